# Optimizing an MI355X kernel written in HIP

```python
import math
import jax
import jax.numpy as jnp
from jax import lax
import numpy as np


D_MODEL = 2048
BATCH = 1
SEQ = 8192
DEPTH = 4

CHUNK = 64
QBLK = 128
EPS = 1e-6
N_MIXERS = 3
ROPE_BASE = 10000.0
PLE_DIM = 256
FFN_HIDDEN = ((8 * D_MODEL // 3 + 255) // 256) * 256

A_HEADS = 16
A_KV_HEADS = 4
A_GROUP = A_HEADS // A_KV_HEADS
A_HEAD_DIM = 128
IDX_HEADS = 16
IDX_DIM = 128
IDX_ROPE = 64
IDX_TOPK_MAX = 256
A_Q = A_HEADS * A_HEAD_DIM
A_KV = A_KV_HEADS * A_HEAD_DIM
A_IDXQ = IDX_HEADS * IDX_DIM
A_SPLITS = (A_Q, A_Q + A_KV, A_Q + 2 * A_KV, A_Q + 2 * A_KV + A_IDXQ, A_Q + 2 * A_KV + A_IDXQ + IDX_DIM)
A_IN = A_SPLITS[-1] + IDX_HEADS

T5_BUCKETS = 32
T5_MAX_DISTANCE = 1024

B_HEADS = 32
B_HEAD_DIM = 64
B_PREV_CHUNKS = 8
B_BAND = (B_PREV_CHUNKS + 1) * CHUNK
B_PAD = B_PREV_CHUNKS * CHUNK
B_REL_CLIP = 128

C_HEADS = 16
C_Q_LORA = 512
C_KV_LORA = 512
C_NOPE = 128
C_ROPE = 64
C_V = 128
C_DOWN = C_Q_LORA + C_KV_LORA + C_ROPE

N_A = (DEPTH + 2) // 3
N_B = (DEPTH + 1) // 3
N_C = DEPTH // 3

kernel_name = "hybrid_dsa_chunkband_mla_trunk"


def rms_norm(x, g):
    xf = x.astype(jnp.float32)
    y = xf * lax.rsqrt(jnp.mean(xf * xf, axis=-1, keepdims=True) + EPS)
    return (y * g.astype(jnp.float32)).astype(x.dtype)


def rope(x, pos):
    half = x.shape[-1] // 2
    inv = ROPE_BASE ** (-jnp.arange(half, dtype=jnp.float32) * 2.0 / x.shape[-1])
    ang = pos.astype(jnp.float32)[..., None] * inv
    ang = ang.reshape(ang.shape[:2] + (1,) * (x.ndim - 3) + (half,))
    cos, sin = jnp.cos(ang), jnp.sin(ang)
    xf = x.astype(jnp.float32)
    x1, x2 = xf[..., :half], xf[..., half:]
    return jnp.concatenate([x1 * cos - x2 * sin, x1 * sin + x2 * cos], axis=-1).astype(x.dtype)


def t5_bucket(rel):
    nb = T5_BUCKETS // 2
    max_exact = nb // 2
    ret = jnp.where(rel > 0, nb, 0)
    n = jnp.abs(rel)
    nf = jnp.maximum(n, 1).astype(jnp.float32)
    large = max_exact + (jnp.log(nf / max_exact) / math.log(T5_MAX_DISTANCE / max_exact) * (nb - max_exact)).astype(jnp.int32)
    large = jnp.minimum(large, nb - 1)
    return ret + jnp.where(n < max_exact, n, large)


def to_blocks(a, size):
    b, s = a.shape[:2]
    return jnp.moveaxis(a.reshape((b, s // size, size) + a.shape[2:]), 1, 0)


def from_blocks(o):
    o = jnp.moveaxis(o, 0, 1)
    return o.reshape(o.shape[0], o.shape[1] * o.shape[2], o.shape[3])


def swiglu(h, w_in, w_out):
    gu = h @ w_in
    g, u = gu[..., :FFN_HIDDEN], gu[..., FFN_HIDDEN:]
    return (jax.nn.silu(g) * u) @ w_out


def dsa_sparse_attention(h, pos, w_in, w_out, t5_table):
    b, s, _ = h.shape
    topk = min(IDX_TOPK_MAX, s // 4)
    nb = s // QBLK
    q, k, v, qi, ki, wi = jnp.split(h @ w_in, A_SPLITS, axis=-1)
    q = q.reshape(b, s, A_KV_HEADS, A_GROUP, A_HEAD_DIM)
    k = k.reshape(b, s, A_KV_HEADS, A_HEAD_DIM)
    v = v.reshape(b, s, A_KV_HEADS, A_HEAD_DIM)
    qi = qi.reshape(b, s, IDX_HEADS, IDX_DIM)
    qi = jnp.concatenate([rope(qi[..., :IDX_ROPE], pos), qi[..., IDX_ROPE:]], axis=-1)
    ki = jnp.concatenate([rope(ki[..., :IDX_ROPE], pos), ki[..., IDX_ROPE:]], axis=-1)
    wi = wi * IDX_HEADS ** -0.5
    cid = jnp.arange(s) // CHUNK
    take = jax.vmap(lambda a, i: a[i])

    def block(args):
        qb, qib, wib, pb, bi = args
        qc = (bi * QBLK + jnp.arange(QBLK)) // CHUNK
        sc = jnp.einsum('bqhd,bsd->bqhs', qib, ki).astype(jnp.float32) * IDX_DIM ** -0.5
        score = jnp.einsum('bqhs,bqh->bqs', jax.nn.relu(sc), wib.astype(jnp.float32))
        score = jnp.where(cid[None, None, :] <= qc[None, :, None], score, -jnp.inf)
        _, idx = lax.top_k(score, topk)
        valid = cid[idx] <= qc[None, :, None]
        kg = take(k, idx)
        vg = take(v, idx)
        pg = take(pos, idx)
        bias = t5_table[t5_bucket(pg - pb[:, :, None])]
        bias = jnp.moveaxis(bias.reshape(b, QBLK, topk, A_KV_HEADS, A_GROUP), 2, -1)
        logits = jnp.einsum('bqkgd,bqskd->bqkgs', qb, kg).astype(jnp.float32) * A_HEAD_DIM ** -0.5 + bias.astype(jnp.float32)
        logits = jnp.where(valid[:, :, None, None, :], logits, -jnp.inf)
        pr = jax.nn.softmax(logits, axis=-1).astype(vg.dtype)
        o = jnp.einsum('bqkgs,bqskd->bqkgd', pr, vg)
        return o.reshape(b, QBLK, A_HEADS * A_HEAD_DIM)

    o = lax.map(block, (to_blocks(q, QBLK), to_blocks(qi, QBLK), to_blocks(wi, QBLK), to_blocks(pos, QBLK), jnp.arange(nb)))
    return from_blocks(o) @ w_out


def chunk_band_attention(h, pos, w_in, rel_table, w_out):
    b, s, _ = h.shape
    nc = s // CHUNK
    q, k, v = jnp.split(h @ w_in, 3, axis=-1)
    q = q.reshape(b, s, B_HEADS, B_HEAD_DIM)
    k = jnp.pad(k.reshape(b, s, B_HEADS, B_HEAD_DIM), ((0, 0), (B_PAD, 0), (0, 0), (0, 0)))
    v = jnp.pad(v.reshape(b, s, B_HEADS, B_HEAD_DIM), ((0, 0), (B_PAD, 0), (0, 0), (0, 0)))
    pp = jnp.pad(pos, ((0, 0), (B_PAD, 0)))

    def per_chunk(c):
        s0 = c * CHUNK
        qc = lax.dynamic_slice_in_dim(q, s0, CHUNK, axis=1)
        pq = lax.dynamic_slice_in_dim(pos, s0, CHUNK, axis=1)
        kb = lax.dynamic_slice_in_dim(k, s0, B_BAND, axis=1)
        vb = lax.dynamic_slice_in_dim(v, s0, B_BAND, axis=1)
        pb = lax.dynamic_slice_in_dim(pp, s0, B_BAND, axis=1)
        valid = (s0 - B_PAD + jnp.arange(B_BAND)) >= 0
        rel = jnp.clip(pq[:, :, None] - pb[:, None, :], -B_REL_CLIP, B_REL_CLIP) + B_REL_CLIP
        bias = jnp.moveaxis(rel_table[rel], -1, 1)
        logits = jnp.einsum('bqhd,bkhd->bhqk', qc, kb).astype(jnp.float32) * B_HEAD_DIM ** -0.5 + bias.astype(jnp.float32)
        logits = jnp.where(valid, logits, -jnp.inf)
        pr = jax.nn.softmax(logits, axis=-1).astype(vb.dtype)
        o = jnp.einsum('bhqk,bkhd->bqhd', pr, vb)
        return o.reshape(b, CHUNK, B_HEADS * B_HEAD_DIM)

    o = lax.map(per_chunk, jnp.arange(nc))
    return from_blocks(o) @ w_out


def mla_attention(h, pos, w_down, g_q, g_kv, w_uq, w_ukv, w_out):
    b, s, _ = h.shape
    nb = s // QBLK
    cq, ckv, kr = jnp.split(h @ w_down, (C_Q_LORA, C_Q_LORA + C_KV_LORA), axis=-1)
    cq = rms_norm(cq, g_q)
    ckv = rms_norm(ckv, g_kv)
    q = (cq @ w_uq).reshape(b, s, C_HEADS, C_NOPE + C_ROPE)
    qn, qr = q[..., :C_NOPE], rope(q[..., C_NOPE:], pos)
    kv = (ckv @ w_ukv).reshape(b, s, C_HEADS, C_NOPE + C_V)
    kn, v = kv[..., :C_NOPE], kv[..., C_NOPE:]
    kr = rope(kr, pos)
    cid = jnp.arange(s) // CHUNK
    scale = (C_NOPE + C_ROPE) ** -0.5

    def block(args):
        qnb, qrb, bi = args
        qc = (bi * QBLK + jnp.arange(QBLK)) // CHUNK
        logits = (jnp.einsum('bqhd,bkhd->bhqk', qnb, kn) + jnp.einsum('bqhd,bkd->bhqk', qrb, kr)).astype(jnp.float32) * scale
        logits = jnp.where(cid[None, :] <= qc[:, None], logits, -jnp.inf)
        pr = jax.nn.softmax(logits, axis=-1).astype(v.dtype)
        o = jnp.einsum('bhqk,bkhd->bqhd', pr, v)
        return o.reshape(b, QBLK, C_HEADS * C_V)

    o = lax.map(block, (to_blocks(qn, QBLK), to_blocks(qr, QBLK), jnp.arange(nb)))
    return from_blocks(o) @ w_out


def setup_inputs(seed: int = 0) -> dict:
    key = jax.random.key(seed)
    ks = jax.random.split(key, 24)
    f32 = jnp.float32

    def dense(k, shape):
        return jax.random.normal(k, shape, f32) * shape[-2] ** -0.5

    def gain(k, shape):
        return 1.0 + 0.05 * jax.random.normal(k, shape, f32)

    x = jax.random.normal(ks[0], (BATCH, SEQ, D_MODEL), f32)
    p = jax.random.normal(ks[1], (DEPTH, BATCH, SEQ, PLE_DIM), f32)
    offset = jax.random.randint(ks[2], (BATCH, 1), 0, 1024, jnp.int32)
    positions = offset + jnp.arange(SEQ, dtype=jnp.int32)[None, :]
    return {
        "x": x,
        "p": p,
        "positions": positions,
        "t5_table": 0.5 * jax.random.normal(ks[3], (T5_BUCKETS, A_HEADS), f32),
        "a_w_in": dense(ks[4], (N_A, D_MODEL, A_IN)),
        "a_w_out": dense(ks[5], (N_A, A_HEADS * A_HEAD_DIM, D_MODEL)),
        "b_w_in": dense(ks[6], (N_B, D_MODEL, 3 * B_HEADS * B_HEAD_DIM)),
        "b_rel_table": 0.5 * jax.random.normal(ks[7], (N_B, 2 * B_REL_CLIP + 1, B_HEADS), f32),
        "b_w_out": dense(ks[8], (N_B, B_HEADS * B_HEAD_DIM, D_MODEL)),
        "c_w_down": dense(ks[9], (N_C, D_MODEL, C_DOWN)),
        "c_q_norm": gain(ks[10], (N_C, C_Q_LORA)),
        "c_kv_norm": gain(ks[11], (N_C, C_KV_LORA)),
        "c_w_uq": dense(ks[12], (N_C, C_Q_LORA, C_HEADS * (C_NOPE + C_ROPE))),
        "c_w_ukv": dense(ks[13], (N_C, C_KV_LORA, C_HEADS * (C_NOPE + C_V))),
        "c_w_out": dense(ks[14], (N_C, C_HEADS * C_V, D_MODEL)),
        "attn_norm": gain(ks[15], (DEPTH, D_MODEL)),
        "ffn_norm": gain(ks[16], (DEPTH, D_MODEL)),
        "ffn_w_in": dense(ks[17], (DEPTH, D_MODEL, 2 * FFN_HIDDEN)),
        "ffn_w_out": dense(ks[18], (DEPTH, FFN_HIDDEN, D_MODEL)),
        "ple_norm": gain(ks[19], (DEPTH, D_MODEL)),
        "ple_w_gate": dense(ks[20], (DEPTH, D_MODEL, D_MODEL)),
        "ple_w_proj": dense(ks[21], (DEPTH, PLE_DIM, D_MODEL)),
        "final_norm": gain(ks[22], (D_MODEL,)),
    }


def reference(x, p, positions, t5_table, a_w_in, a_w_out, b_w_in, b_rel_table, b_w_out,
              c_w_down, c_q_norm, c_kv_norm, c_w_uq, c_w_ukv, c_w_out,
              attn_norm, ffn_norm, ffn_w_in, ffn_w_out, ple_norm, ple_w_gate, ple_w_proj, final_norm):
    h = x
    for i in range(DEPTH):
        j = i // N_MIXERS
        kind = i % N_MIXERS
        hn = rms_norm(h, attn_norm[i])
        if kind == 0:
            mix = dsa_sparse_attention(hn, positions, a_w_in[j], a_w_out[j], t5_table)
        elif kind == 1:
            mix = chunk_band_attention(hn, positions, b_w_in[j], b_rel_table[j], b_w_out[j])
        else:
            mix = mla_attention(hn, positions, c_w_down[j], c_q_norm[j], c_kv_norm[j], c_w_uq[j], c_w_ukv[j], c_w_out[j])
        h = h + mix
        h = h + swiglu(rms_norm(h, ffn_norm[i]), ffn_w_in[i], ffn_w_out[i])
        gate = jax.nn.sigmoid(rms_norm(h, ple_norm[i]) @ ple_w_gate[i])
        h = h + gate * (p[i] @ ple_w_proj[i])
    return rms_norm(h, final_norm)
```

```cpp
#include <hip/hip_runtime.h>
#include <cstdio>
#include <cstdint>

#define GAS __attribute__((address_space(1)))
#define LAS __attribute__((address_space(3)))
typedef unsigned short bf16_t;
typedef short bf16x8 __attribute__((ext_vector_type(8)));
typedef short s16x4 __attribute__((ext_vector_type(4)));
typedef float f32x2 __attribute__((ext_vector_type(2)));
typedef float f32x4 __attribute__((ext_vector_type(4)));
typedef float f32x16 __attribute__((ext_vector_type(16)));
typedef unsigned u32x2 __attribute__((ext_vector_type(2)));
typedef unsigned u32x4 __attribute__((ext_vector_type(4)));

constexpr int SEQ = 8192, DM = 2048, FFH = 5632, PLE = 256, DEPTH = 4;
constexpr float EPS = 1e-6f;
constexpr float LOG2E = 1.4426950408889634f;
constexpr int A_IN = 5264, A_INP = 5376;
constexpr int AQ_OFF = 0, AK_OFF = 2048, AV_OFF = 2560, AQI_OFF = 3072, AKI_OFF = 5120, AWI_OFF = 5248;
constexpr int TOPK = 256;
constexpr int B_IN = 6144;
constexpr int C_DOWN = 1088, C_DOWNP = 1280, C_UQ = 3072, C_UKV = 4096;

constexpr size_t MiB = 1u << 20;
constexpr size_t WS_CTL = 0, CTL_ZERO_BYTES = 32768;
constexpr size_t WS_CS = 1 * MiB;
constexpr size_t WS_H = 4 * MiB;
constexpr size_t WS_HN = 68 * MiB;
constexpr size_t WS_ACT = 100 * MiB;
constexpr size_t WS_PROJ = 188 * MiB;
constexpr size_t WS_PB = 220 * MiB;
constexpr size_t WS_MIX = 236 * MiB;
constexpr size_t MA_QKVI = WS_MIX, MA_SC = WS_MIX + 84 * MiB, MA_IDX = WS_MIX + 340 * MiB, MA_O = WS_MIX + 348 * MiB;
constexpr size_t MB_QKV = WS_MIX, MB_O = WS_MIX + 96 * MiB;
constexpr size_t MC_CD = WS_MIX, MC_CQN = WS_MIX + 20 * MiB, MC_CKVN = WS_MIX + 28 * MiB, MC_Q = WS_MIX + 36 * MiB, MC_K = WS_MIX + 84 * MiB,
                 MC_V = WS_MIX + 132 * MiB, MC_O = WS_MIX + 164 * MiB;
constexpr size_t WS_W = 620 * MiB;
constexpr size_t W_AIN = 21 * MiB, W_AOUT = 8 * MiB, W_A = W_AIN + W_AOUT;
constexpr size_t WA0 = WS_W, WA1 = WS_W + W_A;
constexpr size_t WB_IN = WS_W + 2 * W_A, WB_OUT = WB_IN + 24 * MiB;
constexpr size_t WC_DOWN = WB_OUT + 8 * MiB, WC_UQ = WC_DOWN + 5 * MiB, WC_UKV = WC_UQ + 3 * MiB, WC_OUT = WC_UKV + 4 * MiB;
constexpr size_t WL0 = WC_OUT + 8 * MiB;
constexpr size_t WL_FIN = 0, WL_FOUT = 44 * MiB, WL_GATE = 66 * MiB, WL_PROJ = 74 * MiB, WL_SIZE = 75 * MiB;
constexpr size_t WS_KV8 = WL0 + 4 * WL_SIZE;
constexpr size_t WS_END = WS_KV8 + 8 * MiB;

constexpr int CW_BAR = 4096;

constexpr int RING_BYTES = 131072;
constexpr int MISC_OFF = RING_BYTES;
constexpr int LDS_BYTES = 147456;
constexpr int NWAVES = 8, NTHREADS = 512;

#define LDS_WAIT() asm volatile("s_waitcnt lgkmcnt(0)" ::: "memory")
#define VM_WAIT() asm volatile("s_waitcnt vmcnt(0)" ::: "memory")

__device__ __forceinline__ unsigned f2bf(float f) { unsigned u = __builtin_bit_cast(unsigned, f); return (u + 0x7fffu + ((u >> 16) & 1u)) >> 16; }
__device__ __forceinline__ unsigned pk2(float lo, float hi) { return f2bf(lo) | (f2bf(hi) << 16); }
__device__ __forceinline__ unsigned cvt_pk_bf16(float lo, float hi) { unsigned r; asm volatile("v_cvt_pk_bf16_f32 %0, %1, %2" : "=v"(r) : "v"(lo), "v"(hi)); return r; }
__device__ __forceinline__ float bf_lo(unsigned w) { return __builtin_bit_cast(float, w << 16); }
__device__ __forceinline__ float bf_hi(unsigned w) { return __builtin_bit_cast(float, w & 0xffff0000u); }
__device__ __forceinline__ int lane_id() { int l; asm volatile("v_mbcnt_lo_u32_b32 %0, -1, 0\n\tv_mbcnt_hi_u32_b32 %0, -1, %0" : "=v"(l)); return l; }
__device__ __forceinline__ float wave_sum(float v) {
#pragma unroll
    for (int o = 1; o < 64; o <<= 1) v += __shfl_xor(v, o);
    return v;
}
__device__ __forceinline__ float wave_max(float v) {
#pragma unroll
    for (int o = 1; o < 64; o <<= 1) v = fmaxf(v, __shfl_xor(v, o));
    return v;
}

#define XB_TMO      128
#define XB_XCNT(j)  (256  + 64 * (j))
#define XB_XSUB(j)  (1280 + 64 * (j))
#define XB_XGEN(j)  (2304 + 64 * (j))
#define XB_TOP      3328
#define XB_TOPGEN   3392
#define XCD_BAR_WORDS 3456
#define XB_SPIN_CAP (1u << 20)

__device__ __forceinline__ unsigned xb_ld(unsigned* p)              { return __hip_atomic_load(p, __ATOMIC_RELAXED, __HIP_MEMORY_SCOPE_AGENT); }
__device__ __forceinline__ unsigned xb_add(unsigned* p, unsigned v) { return __hip_atomic_fetch_add(p, v, __ATOMIC_RELAXED, __HIP_MEMORY_SCOPE_AGENT); }
__device__ __forceinline__ unsigned xb_xcc_id() { return (unsigned)__builtin_amdgcn_s_getreg((3 << 11) | 20) & 0xFu; }
#define XB_SPIN(cond, bar) do { unsigned _sp = 0; while (cond) { __builtin_amdgcn_s_sleep(1); \
    if ((++_sp & 255u) == 0u) { if (xb_ld(&(bar)[XB_TMO])) break; if (_sp > XB_SPIN_CAP) { atomicAdd(&(bar)[XB_TMO], 1u); break; } } } } while (0)

struct XcdBarrier { unsigned* bar; unsigned x; volatile LAS unsigned* st; int wave; };

__device__ __forceinline__ XcdBarrier xcd_barrier_post(unsigned* bar, volatile LAS unsigned* st, int wave) {
    XcdBarrier b; b.bar = bar; b.x = xb_xcc_id(); b.st = st; b.wave = wave;
    if (wave == 0 && lane_id() == 0) { const unsigned rank = xb_add(&bar[XB_XCNT(b.x)], 1u); st[2] = rank; st[3] = b.x; }
    return b;
}
__device__ __forceinline__ void xcd_barrier_complete(unsigned* bar, unsigned x, unsigned& nloc, unsigned& nx) {
    const unsigned G = gridDim.x * gridDim.y * gridDim.z;
    unsigned sum, cnt, mine, sp = 0u;
    for (;;) {
        sum = 0u; cnt = 0u; mine = 0u;
#pragma unroll
        for (unsigned j = 0; j < 16; ++j) { const unsigned c = xb_ld(&bar[XB_XCNT(j)]); sum += c; cnt += (c > 0u) ? 1u : 0u; mine = (j == x) ? c : mine; }
        if (sum == G) break;
        __builtin_amdgcn_s_sleep(1);
        if ((++sp & 255u) == 0u) { if (xb_ld(&bar[XB_TMO])) break; if (sp > XB_SPIN_CAP) { atomicAdd(&bar[XB_TMO], 1u); break; } }
    }
    nloc = mine > 0u ? mine : 1u; nx = cnt > 0u ? cnt : 1u;
}
__device__ __forceinline__ void xcd_barrier(const XcdBarrier& b) {
    asm volatile("s_waitcnt vmcnt(0)" ::: "memory");
    __syncthreads();
    if (b.wave == 0 && lane_id() == 0) {
        unsigned* bar = b.bar;
        __builtin_amdgcn_s_waitcnt(0);
        unsigned nloc = b.st[0], nx = b.st[1];
        if (nloc == 0u) { xcd_barrier_complete(bar, b.x, nloc, nx); b.st[0] = nloc; b.st[1] = nx; }
        const unsigned old = xb_add(&bar[XB_XSUB(b.x)], 1u);
        const unsigned gen = old / nloc;
        if (old + 1u == (gen + 1u) * nloc) {
            __builtin_amdgcn_fence(__ATOMIC_RELEASE, "agent");
            asm volatile("s_waitcnt vmcnt(0)" ::: "memory");
            const unsigned og = xb_add(&bar[XB_TOP], 1u);
            const unsigned tg = og / nx;
            if (og + 1u == (tg + 1u) * nx) xb_add(&bar[XB_TOPGEN], 1u);
            else XB_SPIN(xb_ld(&bar[XB_TOPGEN]) == tg, bar);
            __builtin_amdgcn_fence(__ATOMIC_ACQUIRE, "agent");
            xb_add(&bar[XB_XGEN(b.x)], 1u);
            asm volatile("s_waitcnt vmcnt(0)" ::: "memory");
        } else {
            XB_SPIN(xb_ld(&bar[XB_XGEN(b.x)]) == gen, bar);
            __builtin_amdgcn_fence(__ATOMIC_ACQUIRE, "agent");
            asm volatile("s_waitcnt vmcnt(0)" ::: "memory");
        }
    }
    __syncthreads();
}
#define MERGE_TS 1
namespace pg8 {
constexpr int BM = 256, BK = 64, HALF = 128, HTB = HALF * BK * 2, STAGE_BYTES = 8 * HTB, NXCD = 8, WGM = 4, WGM_NARROW = 4;

__host__ __device__ __forceinline__ int lds_byte(int r, int c) { const int st = (r >> 4) * 2 + (c >> 5), rr = r & 15, cc = c & 31, ob = rr * 64 + cc * 2; return st * 1024 + (ob ^ (((ob >> 9) & 1) << 5)); }
__host__ __device__ __forceinline__ void stage_rc(int b, int& R, int& C) { const int st = b / 1024, sb = b % 1024, swz = sb ^ (((sb >> 9) & 1) << 5); R = (st >> 1) * 16 + swz / 64; C = (st & 1) * 32 + (swz % 64) / 2; }
__host__ __device__ __forceinline__ int perm32(int rho) { const int n = rho >> 4, i = rho & 15; return 8 * (i >> 2) + 4 * n + (i & 3); }

struct Unit { int pm, pn, seq; };
struct Gemm { const bf16_t* A; const bf16_t* Bt; int lda, ldb, K; };

struct BMapPlain { static __device__ __forceinline__ long off(int h, int R, int ldb) { return (long)(h * HALF + R) * ldb; } };
struct BMapPerm  { static __device__ __forceinline__ long off(int h, int R, int ldb) { return (long)(h * HALF + (R & ~31) + perm32(R & 31)) * ldb; } };

struct StaticOrder {
    int nM, nN, nwg, G, c;
    __host__ __device__ void init(int M, int N, int G_, int c_) { nM = M / BM; nN = N / BM; nwg = nM * nN; G = G_; c = c_; }
    __host__ __device__ bool next(int i, Unit& u) const {
        const long L = (long)i * G + c; if (L >= nwg) return false;
        int wgid = (int)L; { const int q = nwg / NXCD, r = nwg % NXCD, xcd = wgid % NXCD, off = wgid / NXCD; wgid = (xcd < r ? xcd * (q + 1) : r * (q + 1) + (xcd - r) * q) + off; }
        const int wgm = nN <= 8 ? WGM_NARROW : WGM;
        const int nig = wgm * nN, gid = wgid / nig, fm = gid * wgm, gsz = (nM - fm) < wgm ? (nM - fm) : wgm;
        u.pm = fm + ((wgid % nig) % gsz); u.pn = (wgid % nig) / gsz; u.seq = i; return true;
    }
    __device__ __forceinline__ long a_off(const Unit& u, int lda) const { return (long)u.pm * BM * lda; }
    __device__ __forceinline__ long b_off(const Unit& u, int ldb) const { return (long)u.pn * BM * ldb; }
};

struct UpperHalfOrder {
    int nN, nwg, G, c;
    __host__ __device__ void init(int M, int N, int G_, int c_) { nN = N / BM; nwg = (M / BM) * nN; G = G_; c = c_; }
    __host__ __device__ bool next(int i, Unit& u) const { const int lo = G / 2; if (c < lo) return false; const int L = (c - lo) + i * (G - lo); if (L >= nwg) return false; u.pm = L / nN; u.pn = L % nN; u.seq = i; return true; }
    __device__ __forceinline__ long a_off(const Unit& u, int lda) const { return (long)u.pm * BM * lda; }
    __device__ __forceinline__ long b_off(const Unit& u, int ldb) const { return (long)u.pn * BM * ldb; }
};

template <class E> __device__ __forceinline__ auto call_pre(const E& e, const Unit& u, int wave, int lane, int) -> decltype(e.pre(u, wave, lane), void()) { e.pre(u, wave, lane); }
template <class E> __device__ __forceinline__ void call_pre(const E&, const Unit&, int, int, long) {}
template <class Epi, class Sched, class BMap>
__device__ __forceinline__ void gemm_phase(LAS unsigned char* lds, int wave, const Gemm g, const Sched& S, const Epi& E) {
    int tid_ = wave * 64 + lane_id(); asm volatile("" : "+v"(tid_));
    const int tid = tid_, wid = wave, lane = tid & 63, wr = wid >> 2, wc = wid & 3, fr = lane & 15, fq = lane >> 4;
    const int K = g.K, nt = K / BK;
    unsigned voffA[2], voffB0[2], voffB1[2];
#pragma unroll
    for (int i = 0; i < 2; ++i) { int R, C; stage_rc(tid * 16 + i * 8192, R, C);
        voffA[i] = (unsigned)(R * g.lda + C) * 2u;
        voffB0[i] = (unsigned)(BMap::off(0, R, g.ldb) + C) * 2u; voffB1[i] = (unsigned)(BMap::off(1, R, g.ldb) + C) * 2u; }
    const size_t kstep = (size_t)(BK * 2);
    const size_t hstepA = (size_t)HALF * g.lda * 2;
    const unsigned ldsw = (unsigned)wid * 1024u;
    const int aoff = lds_byte(wr * 64 + fr, fq * 8), boff = lds_byte(wc * 32 + fr, fq * 8);
#define PG8_SA(b, h) (((b) * 2 + (h)) * HTB)
#define PG8_SB(b, h) ((4 + (b) * 2 + (h)) * HTB)
#define PG8_STAGE(bufoff, gbase, voff) do { _Pragma("unroll") for (int _i = 0; _i < 2; ++_i) \
        __builtin_amdgcn_global_load_lds((const unsigned*)((const char*)(gbase) + (voff)[_i]), (LAS unsigned*)(lds + (bufoff) + ldsw + _i * 8192), 16, 0, 0); } while (0)
#define PG8_LDA(dst, b, h) do { _Pragma("unroll") for (int m = 0; m < 4; ++m) _Pragma("unroll") for (int k = 0; k < 2; ++k) dst[m][k] = *(const LAS bf16x8*)(lds + PG8_SA(b, h) + aoff + m * 2048 + k * 1024); } while (0)
#define PG8_LDB(dst, b, h) do { _Pragma("unroll") for (int n = 0; n < 2; ++n) _Pragma("unroll") for (int k = 0; k < 2; ++k) dst[n][k] = *(const LAS bf16x8*)(lds + PG8_SB(b, h) + boff + n * 2048 + k * 1024); } while (0)
#define PG8_MMA(ai, bj, At, Bt) do { __builtin_amdgcn_s_setprio(1); _Pragma("unroll") for (int m = 0; m < 4; ++m) _Pragma("unroll") for (int n = 0; n < 2; ++n) _Pragma("unroll") for (int k = 0; k < 2; ++k) \
        acc[ai][bj][m][n] = __builtin_amdgcn_mfma_f32_16x16x32_bf16(Bt[n][k], At[m][k], acc[ai][bj][m][n], 0, 0, 0); __builtin_amdgcn_s_setprio(0); } while (0)
#define PG8_WAIT_V(n) asm volatile("s_waitcnt vmcnt(" #n ")" ::: "memory")
#define PG8_WAIT_L(n) asm volatile("s_waitcnt lgkmcnt(" #n ")" ::: "memory")
#define PG8_BAR __builtin_amdgcn_s_barrier()
#define PG8_SCHED __builtin_amdgcn_sched_barrier(0)
    Unit cur, nxt; int ui = 0;
    if (!S.next(0, cur)) return;
    f32x4 acc[2][2][4][2];
#pragma unroll
    for (int a = 0; a < 2; ++a)
#pragma unroll
        for (int b = 0; b < 2; ++b)
#pragma unroll
            for (int m = 0; m < 4; ++m)
#pragma unroll
                for (int n = 0; n < 2; ++n) acc[a][b][m][n] = (f32x4){0.f, 0.f, 0.f, 0.f};
    bf16x8 At[4][2], B0[2][2], B1[2][2];
    const char* cA = (const char*)(g.A + S.a_off(cur, g.lda)); const char* cB = (const char*)(g.Bt + S.b_off(cur, g.ldb));
    call_pre(E, cur, wid, lane, 0);
    PG8_STAGE(PG8_SB(0, 0), cB, voffB0); PG8_STAGE(PG8_SB(0, 1), cB, voffB1); PG8_STAGE(PG8_SA(0, 0), cA, voffA); PG8_STAGE(PG8_SA(0, 1), cA + hstepA, voffA);
    if (wr == 1) PG8_BAR;
    PG8_WAIT_V(2); PG8_BAR;
    PG8_STAGE(PG8_SB(1, 0), cB + kstep, voffB0); PG8_STAGE(PG8_SA(1, 0), cA + kstep, voffA); PG8_STAGE(PG8_SB(1, 1), cB + kstep, voffB1);
    PG8_WAIT_V(6); PG8_BAR;
#pragma unroll 1
    for (;;) {
        const bool has_next = S.next(ui + 1, nxt);
        const char* nA = has_next ? (const char*)(g.A + S.a_off(nxt, g.lda)) : cA; const char* nB = has_next ? (const char*)(g.Bt + S.b_off(nxt, g.ldb)) : cB;
#pragma unroll 1
        for (int t = 0; t < nt; t += 2) {
            const bool last = (t == nt - 2);
            const char* a1 = cA + (size_t)(t + 1) * kstep;
            const char* a2 = last ? nA : cA + (size_t)(t + 2) * kstep; const char* b2 = last ? nB : cB + (size_t)(t + 2) * kstep;
            const char* a3 = a2 + kstep; const char* b3 = b2 + kstep;
            PG8_LDB(B0, 0, 0); PG8_LDB(B1, 0, 1); PG8_SCHED; PG8_LDA(At, 0, 0); PG8_STAGE(PG8_SA(1, 1), a1 + hstepA, voffA);
            PG8_WAIT_V(8); PG8_WAIT_L(0); PG8_BAR; PG8_MMA(0, 0, At, B0); PG8_MMA(0, 1, At, B1); PG8_BAR; PG8_SCHED;
            PG8_LDA(At, 0, 1); PG8_STAGE(PG8_SB(0, 0), b2, voffB0); PG8_STAGE(PG8_SB(0, 1), b2, voffB1); PG8_STAGE(PG8_SA(0, 0), a2, voffA);
            PG8_WAIT_V(8); PG8_WAIT_L(0); PG8_BAR; PG8_MMA(1, 0, At, B0); PG8_MMA(1, 1, At, B1); PG8_BAR; PG8_SCHED;
            PG8_LDB(B0, 1, 0); PG8_LDB(B1, 1, 1); PG8_SCHED; PG8_LDA(At, 1, 0); PG8_STAGE(PG8_SA(0, 1), a2 + hstepA, voffA);
            PG8_WAIT_V(8); PG8_WAIT_L(0); PG8_BAR; PG8_MMA(0, 0, At, B0); PG8_MMA(0, 1, At, B1); PG8_BAR; PG8_SCHED;
            PG8_LDA(At, 1, 1); PG8_STAGE(PG8_SB(1, 0), b3, voffB0); PG8_STAGE(PG8_SB(1, 1), b3, voffB1); PG8_STAGE(PG8_SA(1, 0), a3, voffA);
            PG8_WAIT_V(8); PG8_WAIT_L(0); PG8_BAR; PG8_MMA(1, 0, At, B0); PG8_MMA(1, 1, At, B1); PG8_BAR; PG8_SCHED;
        }
        if (wr == 0) PG8_BAR;
        E(acc, cur, wr, wc, fr, fq);
        if (!has_next) break;
        call_pre(E, nxt, wid, lane, 0);
#pragma unroll
        for (int a = 0; a < 2; ++a)
#pragma unroll
            for (int b = 0; b < 2; ++b)
#pragma unroll
                for (int m = 0; m < 4; ++m)
#pragma unroll
                    for (int n = 0; n < 2; ++n) acc[a][b][m][n] = (f32x4){0.f, 0.f, 0.f, 0.f};
        cur = nxt; cA = nA; cB = nB; ++ui;
        if (wr == 1) PG8_BAR;
    }
    PG8_WAIT_V(0);
    PG8_BAR;
#undef PG8_SA
#undef PG8_SB
#undef PG8_STAGE
#undef PG8_LDA
#undef PG8_LDB
#undef PG8_MMA
#undef PG8_WAIT_V
#undef PG8_WAIT_L
#undef PG8_BAR
#undef PG8_SCHED
}

struct EpiBf16 {
    bf16_t* O; int ldc;
    __device__ __forceinline__ void operator()(const f32x4 (&acc)[2][2][4][2], const Unit& u, int wr, int wc, int fr_, int fq) const {
        int fr = fr_; asm volatile("" : "+v"(fr));
        const int row0 = u.pm * BM + wr * 64 + fr, col0 = u.pn * BM + wc * 32 + 8 * fq;
#pragma unroll
        for (int ai = 0; ai < 2; ++ai)
#pragma unroll
            for (int m = 0; m < 4; ++m) { bf16_t* rowp = O + (size_t)(row0 + ai * HALF + m * 16) * ldc + col0;
#pragma unroll
                for (int bj = 0; bj < 2; ++bj) { const f32x4 v0 = acc[ai][bj][m][0], v1 = acc[ai][bj][m][1];
                    u32x4 w; w.x = cvt_pk_bf16(v0[0], v0[1]); w.y = cvt_pk_bf16(v0[2], v0[3]); w.z = cvt_pk_bf16(v1[0], v1[1]); w.w = cvt_pk_bf16(v1[2], v1[3]);
                    *(u32x4*)(rowp + bj * HALF) = w; } }
    }
};
template <class Sel> struct EpiRope {
    bf16_t* O; int ldc; const f32x2* cs; unsigned char* kv8;
    __device__ __forceinline__ void operator()(const f32x4 (&acc)[2][2][4][2], const Unit& u, int wr, int wc, int fr_, int fq) const {
        int fr = fr_; asm volatile("" : "+v"(fr));
        const int row0 = u.pm * BM + wr * 64 + fr, col0 = u.pn * BM + wc * 32 + 8 * fq;
        const bool any = Sel::tile_any(u.pn);
#pragma unroll
        for (int ai = 0; ai < 2; ++ai)
#pragma unroll
            for (int m = 0; m < 4; ++m) { const int row = row0 + ai * HALF + m * 16; bf16_t* rowp = O + (size_t)row * ldc + col0;
#pragma unroll
                for (int bj = 0; bj < 2; ++bj) { f32x4 v0 = acc[ai][bj][m][0], v1 = acc[ai][bj][m][1];
                    if (any) { const int j0 = Sel::j0(col0 + bj * HALF);
                        if (j0 >= 0) { const f32x4 c01 = *(const f32x4*)(cs + (size_t)row * 32 + j0), c23 = *(const f32x4*)(cs + (size_t)row * 32 + j0 + 2);
                            f32x4 r0, r1;
                            r0[0] = v0[0] * c01[0] - v0[1] * c01[1]; r0[1] = v0[0] * c01[1] + v0[1] * c01[0];
                            r0[2] = v0[2] * c01[2] - v0[3] * c01[3]; r0[3] = v0[2] * c01[3] + v0[3] * c01[2];
                            r1[0] = v1[0] * c23[0] - v1[1] * c23[1]; r1[1] = v1[0] * c23[1] + v1[1] * c23[0];
                            r1[2] = v1[2] * c23[2] - v1[3] * c23[3]; r1[3] = v1[2] * c23[3] + v1[3] * c23[2];
                            v0 = r0; v1 = r1; } }
                    u32x4 w; w.x = cvt_pk_bf16(v0[0], v0[1]); w.y = cvt_pk_bf16(v0[2], v0[3]); w.z = cvt_pk_bf16(v1[0], v1[1]); w.w = cvt_pk_bf16(v1[2], v1[3]);
                    *(u32x4*)(rowp + bj * HALF) = w;
                    if (kv8 && (u.pn >> 2) == 2) { int a = __builtin_amdgcn_cvt_pk_fp8_f32(v0[0], v0[1], 0, false); a = __builtin_amdgcn_cvt_pk_fp8_f32(v0[2], v0[3], a, true);
                        int b = __builtin_amdgcn_cvt_pk_fp8_f32(v1[0], v1[1], 0, false); b = __builtin_amdgcn_cvt_pk_fp8_f32(v1[2], v1[3], b, true);
                        const int cc = col0 + bj * HALF - 2048;
                        *(u32x2*)(kv8 + (size_t)(cc >> 7) * (SEQ * 128) + (size_t)row * 128 + (cc & 127)) = (u32x2){(unsigned)a, (unsigned)b}; } } }
    }
};
struct EpiUkv {
    bf16_t* Kb; bf16_t* Vb;
    __device__ __forceinline__ void operator()(const f32x4 (&acc)[2][2][4][2], const Unit& u, int wr, int wc, int fr_, int fq) const {
        int fr = fr_; asm volatile("" : "+v"(fr));
        const int row0 = u.pm * BM + wr * 64 + fr, c0 = wc * 32 + 8 * fq;
#pragma unroll
        for (int ai = 0; ai < 2; ++ai)
#pragma unroll
            for (int m = 0; m < 4; ++m) { const size_t row = (size_t)(row0 + ai * HALF + m * 16);
#pragma unroll
                for (int bj = 0; bj < 2; ++bj) { const f32x4 v0 = acc[ai][bj][m][0], v1 = acc[ai][bj][m][1];
                    u32x4 w; w.x = cvt_pk_bf16(v0[0], v0[1]); w.y = cvt_pk_bf16(v0[2], v0[3]); w.z = cvt_pk_bf16(v1[0], v1[1]); w.w = cvt_pk_bf16(v1[2], v1[3]);
                    bf16_t* p = bj == 0 ? Kb + row * 3072 + u.pn * 192 + c0 : Vb + row * 2048 + u.pn * 128 + c0;
                    *(u32x4*)p = w; } }
    }
};
struct EpiResid {
    const float* base; float* out; int ldc;
    __device__ __forceinline__ void operator()(const f32x4 (&acc)[2][2][4][2], const Unit& u, int wr, int wc, int fr_, int fq) const {
        int fr = fr_; asm volatile("" : "+v"(fr));
        const int row0 = u.pm * BM + wr * 64 + fr, col0 = u.pn * BM + wc * 32 + 4 * fq;
#pragma unroll
        for (int ai = 0; ai < 2; ++ai)
#pragma unroll
            for (int m = 0; m < 4; ++m) { const size_t off = (size_t)(row0 + ai * HALF + m * 16) * ldc + col0;
#pragma unroll
                for (int bj = 0; bj < 2; ++bj)
#pragma unroll
                    for (int n = 0; n < 2; ++n) { const f32x4 b = *(const f32x4*)(base + off + bj * HALF + n * 16); *(f32x4*)(out + off + bj * HALF + n * 16) = b + acc[ai][bj][m][n]; }
                if (m & 1) asm volatile("" ::: "memory"); }
    }
};
struct EpiNull { float* sink;
    __device__ __forceinline__ void operator()(const f32x4 (&acc)[2][2][4][2], const Unit& u, int wr, int wc, int fr, int fq) const {
        float t = 0.f;
#pragma unroll
        for (int ai = 0; ai < 2; ++ai)
#pragma unroll
            for (int bj = 0; bj < 2; ++bj)
#pragma unroll
                for (int m = 0; m < 4; ++m)
#pragma unroll
                    for (int n = 0; n < 2; ++n) t += acc[ai][bj][m][n][0];
        if (t == 123.456f) sink[0] = t; } };
struct EpiSwiGLU {
    bf16_t* O; int ldc;
    static __device__ __forceinline__ float silu_mul(float g, float u) { return g * u * __builtin_amdgcn_rcpf(1.0f + __builtin_amdgcn_exp2f(-g * LOG2E)); }
    __device__ __forceinline__ void operator()(const f32x4 (&acc)[2][2][4][2], const Unit& u, int wr, int wc, int fr_, int fq) const {
        int fr = fr_; asm volatile("" : "+v"(fr));
        const int row0 = u.pm * BM + wr * 64 + fr, col0 = u.pn * HALF + wc * 32 + 8 * fq;
#pragma unroll
        for (int ai = 0; ai < 2; ++ai)
#pragma unroll
            for (int m = 0; m < 4; ++m) { bf16_t* rowp = O + (size_t)(row0 + ai * HALF + m * 16) * ldc + col0;
                const f32x4 g0 = acc[ai][0][m][0], g1 = acc[ai][0][m][1], u0 = acc[ai][1][m][0], u1 = acc[ai][1][m][1];
                u32x4 w; w.x = cvt_pk_bf16(silu_mul(g0[0], u0[0]), silu_mul(g0[1], u0[1])); w.y = cvt_pk_bf16(silu_mul(g0[2], u0[2]), silu_mul(g0[3], u0[3]));
                w.z = cvt_pk_bf16(silu_mul(g1[0], u1[0]), silu_mul(g1[1], u1[1])); w.w = cvt_pk_bf16(silu_mul(g1[2], u1[2]), silu_mul(g1[3], u1[3]));
                *(u32x4*)rowp = w; }
    }
};
struct EpiPLE {
    float* h; const bf16_t* proj; int ldc;
    __device__ __forceinline__ void operator()(const f32x4 (&acc)[2][2][4][2], const Unit& u, int wr, int wc, int fr_, int fq) const {
        int fr = fr_; asm volatile("" : "+v"(fr));
        const int row0 = u.pm * BM + wr * 64 + fr, col0 = u.pn * BM + wc * 32 + 4 * fq;
#pragma unroll
        for (int ai = 0; ai < 2; ++ai)
#pragma unroll
            for (int m = 0; m < 4; ++m) { const size_t off = (size_t)(row0 + ai * HALF + m * 16) * ldc + col0;
#pragma unroll
                for (int bj = 0; bj < 2; ++bj)
#pragma unroll
                    for (int n = 0; n < 2; ++n) { const size_t o = off + bj * HALF + n * 16; const f32x4 b = *(const f32x4*)(h + o); const u32x2 pw = *(const u32x2*)(proj + o);
                        const f32x4 a = acc[ai][bj][m][n]; f32x4 r;
                        r[0] = b[0] + bf_lo(pw.x) * __builtin_amdgcn_rcpf(1.0f + __builtin_amdgcn_exp2f(-a[0] * LOG2E));
                        r[1] = b[1] + bf_hi(pw.x) * __builtin_amdgcn_rcpf(1.0f + __builtin_amdgcn_exp2f(-a[1] * LOG2E));
                        r[2] = b[2] + bf_lo(pw.y) * __builtin_amdgcn_rcpf(1.0f + __builtin_amdgcn_exp2f(-a[2] * LOG2E));
                        r[3] = b[3] + bf_hi(pw.y) * __builtin_amdgcn_rcpf(1.0f + __builtin_amdgcn_exp2f(-a[3] * LOG2E));
                        *(f32x4*)(h + o) = r; }
                if (m & 1) asm volatile("" ::: "memory"); }
    }
};
}
struct Params {
    const float* x; const float* p; const int* pos; const float* t5;
    const float* a_w_in; const float* a_w_out; const float* b_w_in; const float* b_rel; const float* b_w_out;
    const float* c_w_down; const float* c_qn; const float* c_kvn; const float* c_w_uq; const float* c_w_ukv; const float* c_w_out;
    const float* attn_norm; const float* ffn_norm; const float* ffn_w_in; const float* ffn_w_out; const float* ple_norm; const float* ple_w_gate; const float* ple_w_proj;
    const float* final_norm;
    float* out; unsigned char* ws;
};
struct ParamsG {
    const float GAS* x; const float GAS* p; const int GAS* pos; const float GAS* t5;
    const float GAS* a_w_in; const float GAS* a_w_out; const float GAS* b_w_in; const float GAS* b_rel; const float GAS* b_w_out;
    const float GAS* c_w_down; const float GAS* c_qn; const float GAS* c_kvn; const float GAS* c_w_uq; const float GAS* c_w_ukv; const float GAS* c_w_out;
    const float GAS* attn_norm; const float GAS* ffn_norm; const float GAS* ffn_w_in; const float GAS* ffn_w_out; const float GAS* ple_norm; const float GAS* ple_w_gate; const float GAS* ple_w_proj;
    const float GAS* final_norm;
    float GAS* out; unsigned char GAS* ws;
};
static_assert(sizeof(ParamsG) == sizeof(Params), "device view of the kernel argument");
typedef const ParamsG __attribute__((address_space(4))) KParams;
typedef KParams& KP;
__device__ __forceinline__ KParams* kparams() { KParams* kp = (KParams*)__builtin_amdgcn_kernarg_segment_ptr(); asm volatile("" : "+s"(kp)); return kp; }
template <class T> __device__ __forceinline__ T* G(T GAS* p) { return (T*)p; }
struct Frame {
    LAS unsigned char* lds;
    int wave;
    int G, bid;
    int gw, NGW;
};

struct CMapId { int nsrc; __device__ __forceinline__ int operator()(int n) const { return n < nsrc ? n : -1; } };
struct CMapAin {
    __device__ __forceinline__ int operator()(int n) const {
        if (n < AQI_OFF) return n;
        if (n < AWI_OFF) { const int r = n - AQI_OFF, hd = r >> 7, dp = r & 127; const int d = dp < 64 ? ((dp >> 1) + 32 * (dp & 1)) : dp; return AQI_OFF + hd * 128 + d; }
        return n < A_IN ? n : -1; }
};
struct CMapFfn {
    __device__ __forceinline__ int operator()(int n) const { const int t = n >> 8, s = (n >> 7) & 1, j = n & 127; return s * FFH + 128 * t + j; }
};
struct CMapUq {
    __device__ __forceinline__ int operator()(int n) const { const int h = n / 192, dp = n - h * 192; if (dp < 128) return n; const int r = dp - 128; return h * 192 + 128 + (r >> 1) + 32 * (r & 1); }
};
template <class CM>
__device__ __forceinline__ void convert_matrix(const Frame& F, const float* W, int K, int Nsrc, bf16_t* WT, int Npad, const CM cm, const float* gain, int& rot) {
    LAS float* scr = (LAS float*)(F.lds + F.wave * 16384);
    const int nblk = Npad / 32, nitems = (K / 64) * nblk, lane = lane_id();
    int start = F.gw - rot; if (start < 0) start += F.NGW;
    rot = (rot + nitems) % F.NGW;
    const int n4 = lane & 7, kr = lane >> 3;
    for (int item = start; item < nitems; item += F.NGW) {
        const int kb = item / nblk, nb = item - kb * nblk, k0 = 64 * kb, n0 = 32 * nb;
        const int s0 = cm(n0 + 4 * n4), s1 = cm(n0 + 4 * n4 + 1), s2 = cm(n0 + 4 * n4 + 2), s3 = cm(n0 + 4 * n4 + 3);
        const bool vec = s0 >= 0 && s1 == s0 + 1 && s2 == s0 + 2 && s3 == s0 + 3 && (s0 & 3) == 0;
        const float* src = W + (size_t)(k0 + kr) * Nsrc;
        f32x4 v[8];
        if (vec) {
#pragma unroll
            for (int i = 0; i < 8; ++i) v[i] = *(const f32x4*)(src + (size_t)(8 * i) * Nsrc + s0);
        } else {
#pragma unroll
            for (int i = 0; i < 8; ++i) { const float* r = src + (size_t)(8 * i) * Nsrc;
                v[i].x = s0 >= 0 ? r[s0] : 0.f; v[i].y = s1 >= 0 ? r[s1] : 0.f; v[i].z = s2 >= 0 ? r[s2] : 0.f; v[i].w = s3 >= 0 ? r[s3] : 0.f; }
        }
#pragma unroll
        for (int i = 0; i < 8; ++i) { const int kk = kr + 8 * i; f32x4 x = v[i]; if (gain) x = x * gain[k0 + kk];
            LAS float* d = scr + kk * 33 + 4 * n4; d[0] = x.x; d[1] = x.y; d[2] = x.z; d[3] = x.w; }
        LDS_WAIT(); asm volatile("" ::: "memory");
        const int c = lane & 7;
#pragma unroll
        for (int j = 0; j < 4; ++j) { const int n = (lane >> 3) + 8 * j; const LAS float* s = scr + (8 * c) * 33 + n;
            u32x4 o; o.x = pk2(s[0 * 33], s[1 * 33]); o.y = pk2(s[2 * 33], s[3 * 33]); o.z = pk2(s[4 * 33], s[5 * 33]); o.w = pk2(s[6 * 33], s[7 * 33]);
            *(GAS u32x4*)(WT + (size_t)(n0 + n) * K + k0 + 8 * c) = o; }
        LDS_WAIT(); asm volatile("" ::: "memory");
    }
}
template <bool OUT_F32>
__device__ __forceinline__ void norm_rows(const Frame& F, const float* src, const float* gain, void* dst) {
    const int lane = lane_id();
    for (int m = F.gw; m < SEQ; m += F.NGW) {
        const GAS f32x4* xr = (const GAS f32x4*)(src + (size_t)m * DM) + lane;
        f32x4 v[8]; float s = 0.f;
#pragma unroll
        for (int j = 0; j < 8; ++j) { v[j] = xr[64 * j]; s += (v[j].x * v[j].x + v[j].y * v[j].y) + (v[j].z * v[j].z + v[j].w * v[j].w); }
        const float rs = 1.0f / sqrtf(wave_sum(s) * (1.f / DM) + EPS);
#pragma unroll
        for (int j = 0; j < 8; ++j) { const f32x4 g = *((const GAS f32x4*)gain + lane + 64 * j); const f32x4 o = v[j] * rs * g;
            if (OUT_F32) *((GAS f32x4*)((float*)dst + (size_t)m * DM) + lane + 64 * j) = o;
            else { u32x2 w; w.x = pk2(o.x, o.y); w.y = pk2(o.z, o.w); *((GAS u32x2*)((bf16_t*)dst + (size_t)m * DM) + lane + 64 * j) = w; } }
    }
}
__device__ __forceinline__ void p0_prologue(const Frame& F, KP P) {
    unsigned char* ws = G(P.ws);
    { f32x2* cs = (f32x2*)(ws + WS_CS); const int gt = F.bid * NTHREADS + F.wave * 64 + lane_id(), NT = F.G * NTHREADS;
      for (int i = gt; i < SEQ * 32; i += NT) { const int row = i >> 5, j = i & 31;
          const double inv = exp(-(double)j * (9.210340371976184 / 32.0)); double t = (double)G(P.pos)[row] * inv * 0.15915494309189535; t -= floor(t);
          const float tf = (float)t; cs[i] = (f32x2){__builtin_amdgcn_cosf(tf), __builtin_amdgcn_sinf(tf)}; }
      const f32x4* p4 = (const f32x4*)G(P.p); u32x2* pb = (u32x2*)(ws + WS_PB);
      for (int i = gt; i < DEPTH * SEQ * PLE / 4; i += NT) { const f32x4 v = p4[i]; u32x2 w; w.x = pk2(v.x, v.y); w.y = pk2(v.z, v.w); pb[i] = w; } }
    int rot = 0;
    for (int j = 0; j < 2; ++j) {
        convert_matrix(F, G(P.a_w_in) + (size_t)j * DM * A_IN, DM, A_IN, (bf16_t*)(ws + (j ? WA1 : WA0)), A_INP, CMapAin{}, nullptr, rot);
        convert_matrix(F, G(P.a_w_out) + (size_t)j * DM * DM, DM, DM, (bf16_t*)(ws + (j ? WA1 : WA0) + W_AIN), DM, CMapId{DM}, nullptr, rot);
    }
    convert_matrix(F, G(P.b_w_in), DM, B_IN, (bf16_t*)(ws + WB_IN), B_IN, CMapId{B_IN}, nullptr, rot);
    convert_matrix(F, G(P.b_w_out), DM, DM, (bf16_t*)(ws + WB_OUT), DM, CMapId{DM}, nullptr, rot);
    convert_matrix(F, G(P.c_w_down), DM, C_DOWN, (bf16_t*)(ws + WC_DOWN), C_DOWNP, CMapId{C_DOWN}, nullptr, rot);
    convert_matrix(F, G(P.c_w_uq), 512, C_UQ, (bf16_t*)(ws + WC_UQ), C_UQ, CMapUq{}, nullptr, rot);
    convert_matrix(F, G(P.c_w_ukv), 512, C_UKV, (bf16_t*)(ws + WC_UKV), C_UKV, CMapId{C_UKV}, nullptr, rot);
    convert_matrix(F, G(P.c_w_out), DM, DM, (bf16_t*)(ws + WC_OUT), DM, CMapId{DM}, nullptr, rot);
    for (int i = 0; i < DEPTH; ++i) {
        unsigned char* wl = ws + WL0 + (size_t)i * WL_SIZE;
        convert_matrix(F, G(P.ffn_w_in) + (size_t)i * DM * 2 * FFH, DM, 2 * FFH, (bf16_t*)(wl + WL_FIN), 2 * FFH, CMapFfn{}, nullptr, rot);
        convert_matrix(F, G(P.ffn_w_out) + (size_t)i * FFH * DM, FFH, DM, (bf16_t*)(wl + WL_FOUT), DM, CMapId{DM}, nullptr, rot);
        convert_matrix(F, G(P.ple_w_gate) + (size_t)i * DM * DM, DM, DM, (bf16_t*)(wl + WL_GATE), DM, CMapId{DM}, nullptr, rot);
        convert_matrix(F, G(P.ple_w_proj) + (size_t)i * PLE * DM, PLE, DM, (bf16_t*)(wl + WL_PROJ), DM, CMapId{DM}, nullptr, rot);
    }
}
#ifndef REP_BAND
#define REP_BAND 1
#endif
#ifndef REP_MLA
#define REP_MLA 1
#endif
#ifndef REP_IDX
#define REP_IDX 1
#endif
#ifndef REP_TOPK
#define REP_TOPK 1
#endif
#ifndef REP_SPARSE
#define REP_SPARSE 1
#endif
#ifndef REP_PRO
#define REP_PRO 1
#endif
#ifndef REP_FFNIN
#define REP_FFNIN 1
#endif
#ifndef REP_NORM
#define REP_NORM 1
#endif
#define GRID_BAR() xcd_barrier(bar)

template <class Epi, class BMap>
__device__ __forceinline__ void run_gemm(const Frame& F, const bf16_t* A, int lda, const bf16_t* Bt, int ldb, int K, int N, const Epi& E) {
    pg8::Gemm g{A, Bt, lda, ldb, K}; pg8::StaticOrder S; S.init(SEQ, N, F.G, F.bid);
    pg8::gemm_phase<Epi, pg8::StaticOrder, BMap>(F.lds, F.wave, g, S, E);
}

namespace fa {
typedef short v4i16_t __attribute__((ext_vector_type(4)));
constexpr int LDS_K = 0, KBUF = 24576, LDS_V = 49152, VBUF = 16384, LDS_WS = 81920, LDS_POS = 83968, LDS_TAB = 84480;
__device__ __forceinline__ int crow(int r, int hi) { return (r & 3) + 8 * (r >> 2) + 4 * hi; }
template <int DQK> __device__ __forceinline__ int kswz(int row, int colB) { return row * (DQK * 2) + (colB ^ ((row & 7) << 4)); }
template <int DV> __device__ __forceinline__ int v_st(int k, int c) { const int kk = (k & ~0xC) | ((k & 4) << 1) | ((k & 8) >> 1); return ((kk >> 3) * (DV / 32) + (c >> 5)) * 512 + ((kk & 7) * 32 + (c & 31)) * 2; }
__device__ __forceinline__ int v_rd_base(int lane) { return ((lane & 3) << 3) | (((lane >> 2) & 3) << 6) | (((lane >> 4) & 1) << 5) | (((lane >> 5) & 1) << 8); }
template <int DV> constexpr int v_rd_off(int d0, int ks, int half) { return d0 * 512 + ks * (1024 * (DV / 32)) + half * (512 * (DV / 32)); }
__device__ __forceinline__ s16x4 vtr(const LAS char* p) { return __builtin_bit_cast(s16x4, __builtin_amdgcn_ds_read_tr16_b64_v4i16((LAS v4i16_t*)p)); }

template <int DQK, int DV, bool BIAS>
__device__ __forceinline__ void attn_block(LAS char* lds, int wave, const bf16_t* Q, int ldq, const bf16_t* K, int ldk, const bf16_t* V, int ldv, bf16_t* O, int ldo,
                                           int c0, int wch, float c2, const int* pos) {
    const int lane = lane_id(), tid = wave * 64 + lane, r32 = lane & 31, hi = lane >> 5;
    constexpr int ND = DQK / 16, NO = DV / 32;
    LAS float* wsf = (LAS float*)(lds + LDS_WS) + wave * 64;
    const LAS float* tab = (const LAS float*)(lds + LDS_TAB);
    const int cq = c0 + (wave >> 1);
    const int t_lo = (c0 - wch) > 0 ? (c0 - wch) : 0, t_hi = c0 + 3;
    const int a_lo = cq - wch, a_hi = cq;
    bf16x8 qr[ND];
#pragma unroll
    for (int d0 = 0; d0 < ND; ++d0) qr[d0] = *(const bf16x8*)(Q + (size_t)(wave * 32 + r32) * ldq + d0 * 16 + hi * 8);
    int posq = 0; if (BIAS) posq = pos[c0 * 64 + wave * 32 + r32];
    float m_reg = -1e30f, l_reg = 0.f; f32x16 o[NO];
#pragma unroll
    for (int d = 0; d < NO; ++d) o[d] = f32x16{};
    const int vrd = v_rd_base(lane);
    int kro[4];
#pragma unroll
    for (int dd = 0; dd < 4; ++dd) kro[dd] = kswz<DQK>(r32, dd * 32 + hi * 16);
    constexpr int KC = 64 * DQK / 8 / 512, VC = 64 * DV / 8 / 512;
    bf16x8 kreg[KC], vreg[VC]; int preg = 0;
#define FA_FETCH(key0_) do { \
        _Pragma("unroll") for (int i_ = 0; i_ < KC; ++i_) { const int ci = tid + 512 * i_, row = ci / (DQK / 8), c8 = ci % (DQK / 8); kreg[i_] = *(const bf16x8*)(K + (size_t)((key0_) + row) * ldk + c8 * 8); } \
        _Pragma("unroll") for (int i_ = 0; i_ < VC; ++i_) { const int ci = tid + 512 * i_, row = ci / (DV / 8), c8 = ci % (DV / 8); vreg[i_] = *(const bf16x8*)(V + (size_t)((key0_) + row) * ldv + c8 * 8); } \
        if (BIAS) { if (tid < 64) preg = pos[(key0_) + tid]; } } while (0)
#define FA_PUT(buf_) do { \
        _Pragma("unroll") for (int i_ = 0; i_ < KC; ++i_) { const int ci = tid + 512 * i_, row = ci / (DQK / 8), c8 = ci % (DQK / 8); *(LAS bf16x8*)(lds + LDS_K + (buf_) * KBUF + kswz<DQK>(row, c8 * 16)) = kreg[i_]; } \
        _Pragma("unroll") for (int i_ = 0; i_ < VC; ++i_) { const int ci = tid + 512 * i_, row = ci / (DV / 8), c8 = ci % (DV / 8); *(LAS bf16x8*)(lds + LDS_V + (buf_) * VBUF + v_st<DV>(row, c8 * 8)) = vreg[i_]; } \
        if (BIAS) { if (tid < 64) *(LAS int*)(lds + LDS_POS + (buf_) * 256 + tid * 4) = preg; } } while (0)
    __syncthreads();
    FA_FETCH(t_lo * 64); FA_PUT(0);
    __syncthreads();
#pragma unroll 1
    for (int t = t_lo; t <= t_hi; ++t) {
        const int cur = (t - t_lo) & 1;
        if (t < t_hi) FA_FETCH((t + 1) * 64);
        if (t >= a_lo && t <= a_hi) {
            const LAS char* kbuf = lds + LDS_K + cur * KBUF; const LAS char* vb = lds + LDS_V + cur * VBUF + vrd;
            const LAS int* posl = (const LAS int*)(lds + LDS_POS + cur * 256);
            f32x16 p0 = f32x16{}, p1 = f32x16{};
            __builtin_amdgcn_s_setprio(1);
#pragma unroll
            for (int d0 = 0; d0 < ND; ++d0) { const LAS char* a = kbuf + kro[d0 & 3] + (d0 >> 2) * 128;
                const bf16x8 b0 = *(const LAS bf16x8*)a, b1 = *(const LAS bf16x8*)(a + 32 * DQK * 2);
                p0 = __builtin_amdgcn_mfma_f32_32x32x16_bf16(b0, qr[d0], p0, 0, 0, 0);
                p1 = __builtin_amdgcn_mfma_f32_32x32x16_bf16(b1, qr[d0], p1, 0, 0, 0); }
            __builtin_amdgcn_s_setprio(0);
#pragma unroll
            for (int r = 0; r < 16; ++r) {
                if (BIAS) { const int kc = crow(r, hi); int d0i = posq - posl[kc], d1i = posq - posl[kc + 32];
                    d0i = d0i < -128 ? -128 : (d0i > 128 ? 128 : d0i); d1i = d1i < -128 ? -128 : (d1i > 128 ? 128 : d1i);
                    p0[r] = fmaf(p0[r], c2, tab[d0i + 128]); p1[r] = fmaf(p1[r], c2, tab[d1i + 128]); }
                else { p0[r] *= c2; p1[r] *= c2; } }
            float pmax = p0[0];
#pragma unroll
            for (int r = 1; r < 16; ++r) pmax = fmaxf(pmax, p0[r]);
#pragma unroll
            for (int r = 0; r < 16; ++r) pmax = fmaxf(pmax, p1[r]);
            { auto rr = __builtin_amdgcn_permlane32_swap(__float_as_uint(pmax), __float_as_uint(pmax), false, false); pmax = fmaxf(__uint_as_float(rr[0]), __uint_as_float(rr[1])); }
            float alpha = 1.f;
            if (!__all((pmax - m_reg) <= 11.5f)) { const float mn = fmaxf(m_reg, pmax); alpha = __builtin_amdgcn_exp2f(m_reg - mn); m_reg = mn; }
            float ps = 0.f;
#pragma unroll
            for (int r = 0; r < 16; ++r) { p0[r] = __builtin_amdgcn_exp2f(p0[r] - m_reg); p1[r] = __builtin_amdgcn_exp2f(p1[r] - m_reg); ps += p0[r] + p1[r]; }
            { auto rr = __builtin_amdgcn_permlane32_swap(__float_as_uint(ps), __float_as_uint(ps), false, false); ps = __uint_as_float(rr[0]) + __uint_as_float(rr[1]); }
            l_reg = l_reg * alpha + ps;
            bf16x8 pa0, pa1, pa2, pa3;
#define FA_PK4(P, B_, OUT) do { const unsigned a0 = cvt_pk_bf16(P[B_ + 0], P[B_ + 1]), a1 = cvt_pk_bf16(P[B_ + 2], P[B_ + 3]); \
        const unsigned b0_ = cvt_pk_bf16(P[B_ + 4], P[B_ + 5]), b1_ = cvt_pk_bf16(P[B_ + 6], P[B_ + 7]); \
        auto r0 = __builtin_amdgcn_permlane32_swap(a0, b0_, false, false); auto r1 = __builtin_amdgcn_permlane32_swap(a1, b1_, false, false); \
        u32x4 w = {r0[0], r1[0], r0[1], r1[1]}; OUT = __builtin_bit_cast(bf16x8, w); } while (0)
            FA_PK4(p0, 0, pa0); FA_PK4(p0, 8, pa1); FA_PK4(p1, 0, pa2); FA_PK4(p1, 8, pa3);
#undef FA_PK4
            if (__any(alpha < 1.f)) { if (hi == 0) wsf[r32] = alpha; LDS_WAIT();
#pragma unroll
                for (int d = 0; d < NO; ++d)
#pragma unroll
                    for (int r = 0; r < 16; ++r) o[d][r] *= wsf[crow(r, hi)];
                LDS_WAIT(); }
            __builtin_amdgcn_s_setprio(1);
#pragma unroll
            for (int d0 = 0; d0 < NO; ++d0) { s16x4 lo[4], hh[4];
#pragma unroll
                for (int ks = 0; ks < 4; ++ks) { lo[ks] = vtr(vb + v_rd_off<DV>(d0, ks, 0)); hh[ks] = vtr(vb + v_rd_off<DV>(d0, ks, 1)); }
#define FA_VF(k) (bf16x8){lo[k][0], lo[k][1], lo[k][2], lo[k][3], hh[k][0], hh[k][1], hh[k][2], hh[k][3]}
                o[d0] = __builtin_amdgcn_mfma_f32_32x32x16_bf16(pa0, FA_VF(0), o[d0], 0, 0, 0);
                o[d0] = __builtin_amdgcn_mfma_f32_32x32x16_bf16(pa1, FA_VF(1), o[d0], 0, 0, 0);
                o[d0] = __builtin_amdgcn_mfma_f32_32x32x16_bf16(pa2, FA_VF(2), o[d0], 0, 0, 0);
                o[d0] = __builtin_amdgcn_mfma_f32_32x32x16_bf16(pa3, FA_VF(3), o[d0], 0, 0, 0);
#undef FA_VF
            }
            __builtin_amdgcn_s_setprio(0);
        }
        if (t < t_hi) FA_PUT(cur ^ 1);
        __syncthreads();
    }
#undef FA_FETCH
#undef FA_PUT
    if (hi == 0) wsf[32 + r32] = l_reg; LDS_WAIT();
#pragma unroll
    for (int r = 0; r < 16; ++r) { const int orow = crow(r, hi); const float rl = __builtin_amdgcn_rcpf(wsf[32 + orow]);
#pragma unroll
        for (int d0 = 0; d0 < NO; ++d0) { const float v = o[d0][r] * rl; const float vn = __shfl_xor(v, 1);
            if ((r32 & 1) == 0) *(unsigned*)(O + (size_t)(wave * 32 + orow) * ldo + d0 * 32 + r32) = cvt_pk_bf16(v, vn); } }
    LDS_WAIT();
}
}
__device__ __forceinline__ int vcu_of(const Frame& F) { return (F.G % 8 == 0) ? (F.bid % 8) * (F.G / 8) + F.bid / 8 : F.bid; }

__device__ __forceinline__ void mixer_b(const Frame& F, KP P, const XcdBarrier& bar) {
    unsigned char* ws = G(P.ws);
    float* h = (float*)(ws + WS_H); bf16_t* hn = (bf16_t*)(ws + WS_HN);
    bf16_t* qkv = (bf16_t*)(ws + MB_QKV); bf16_t* ob = (bf16_t*)(ws + MB_O);
    norm_rows<false>(F, h, G(P.attn_norm) + 1 * DM, hn);
    GRID_BAR();
    run_gemm<pg8::EpiBf16, pg8::BMapPerm>(F, hn, DM, (const bf16_t*)(ws + WB_IN), DM, DM, B_IN, pg8::EpiBf16{qkv, B_IN});
    GRID_BAR();
    {
        const int vcu = vcu_of(F); LAS char* lds = (LAS char*)F.lds;
        for (int rep_ = 0; rep_ < REP_BAND; ++rep_)
        for (int it = vcu; it < 32 * 32; it += F.G) {
            const int head = it >> 5, qb = it & 31;
            __syncthreads();
            { const int tid = F.wave * 64 + lane_id(); if (tid < 257) *(LAS float*)(lds + fa::LDS_TAB + tid * 4) = G(P.b_rel)[tid * 32 + head] * LOG2E; }
            fa::attn_block<64, 64, true>(lds, F.wave, qkv + (size_t)qb * 256 * B_IN + head * 64, B_IN, qkv + 2048 + head * 64, B_IN, qkv + 4096 + head * 64, B_IN,
                                         ob + (size_t)qb * 256 * DM + head * 64, DM, 4 * qb, 8, 0.125f * LOG2E, G(P.pos));
        }
    }
    GRID_BAR();
    run_gemm<pg8::EpiResid, pg8::BMapPlain>(F, ob, DM, (const bf16_t*)(ws + WB_OUT), DM, DM, DM, pg8::EpiResid{h, h, DM});
    GRID_BAR();
}

struct SelUq { static __device__ __forceinline__ bool tile_any(int) { return true; }
               static __device__ __forceinline__ int j0(int col0) { const int r = col0 % 192; return r >= 128 ? ((r - 128) >> 1) : -1; } };
__device__ __forceinline__ void c_mid(const Frame& F, KP P) {
    unsigned char* ws = G(P.ws); const int lane = lane_id();
    const bf16_t* cd = (const bf16_t*)(ws + MC_CD); bf16_t* cqn = (bf16_t*)(ws + MC_CQN); bf16_t* ckvn = (bf16_t*)(ws + MC_CKVN); bf16_t* kb = (bf16_t*)(ws + MC_K);
    const f32x2* cs = (const f32x2*)(ws + WS_CS);
    const f32x4 gq0 = *(const f32x4*)(G(P.c_qn) + 8 * lane), gq1 = *(const f32x4*)(G(P.c_qn) + 8 * lane + 4), gk0 = *(const f32x4*)(G(P.c_kvn) + 8 * lane), gk1 = *(const f32x4*)(G(P.c_kvn) + 8 * lane + 4);
    for (int row = F.gw; row < SEQ; row += F.NGW) {
        const bf16_t* r = cd + (size_t)row * C_DOWNP;
        const u32x4 a = *(const u32x4*)(r + 8 * lane), b = *(const u32x4*)(r + 512 + 8 * lane);
        float x[8] = {bf_lo(a.x), bf_hi(a.x), bf_lo(a.y), bf_hi(a.y), bf_lo(a.z), bf_hi(a.z), bf_lo(a.w), bf_hi(a.w)};
        float y[8] = {bf_lo(b.x), bf_hi(b.x), bf_lo(b.y), bf_hi(b.y), bf_lo(b.z), bf_hi(b.z), bf_lo(b.w), bf_hi(b.w)};
        float sx = 0.f, sy = 0.f;
#pragma unroll
        for (int i = 0; i < 8; ++i) { sx += x[i] * x[i]; sy += y[i] * y[i]; }
        const float rq = 1.0f / sqrtf(wave_sum(sx) * (1.f / 512.f) + EPS), rk = 1.0f / sqrtf(wave_sum(sy) * (1.f / 512.f) + EPS);
        u32x4 wq, wk;
        wq.x = pk2(x[0] * rq * gq0[0], x[1] * rq * gq0[1]); wq.y = pk2(x[2] * rq * gq0[2], x[3] * rq * gq0[3]); wq.z = pk2(x[4] * rq * gq1[0], x[5] * rq * gq1[1]); wq.w = pk2(x[6] * rq * gq1[2], x[7] * rq * gq1[3]);
        wk.x = pk2(y[0] * rk * gk0[0], y[1] * rk * gk0[1]); wk.y = pk2(y[2] * rk * gk0[2], y[3] * rk * gk0[3]); wk.z = pk2(y[4] * rk * gk1[0], y[5] * rk * gk1[1]); wk.w = pk2(y[6] * rk * gk1[2], y[7] * rk * gk1[3]);
        *(u32x4*)(cqn + (size_t)row * 512 + 8 * lane) = wq; *(u32x4*)(ckvn + (size_t)row * 512 + 8 * lane) = wk;
        if (lane < 32) { const float x1 = bf_lo((unsigned)r[1024 + lane]), x2 = bf_lo((unsigned)r[1024 + 32 + lane]); const f32x2 c = cs[(size_t)row * 32 + lane];
            const unsigned w = pk2(x1 * c.x - x2 * c.y, x1 * c.y + x2 * c.x);
#pragma unroll
            for (int hd = 0; hd < 16; ++hd) *(unsigned*)(kb + (size_t)row * 3072 + hd * 192 + 128 + 2 * lane) = w; }
    }
}
__device__ __forceinline__ void mixer_c(const Frame& F, KP P, const XcdBarrier& bar) {
    unsigned char* ws = G(P.ws);
    float* h = (float*)(ws + WS_H); bf16_t* hn = (bf16_t*)(ws + WS_HN);
    bf16_t* cd = (bf16_t*)(ws + MC_CD); bf16_t* cqn = (bf16_t*)(ws + MC_CQN); bf16_t* ckvn = (bf16_t*)(ws + MC_CKVN);
    bf16_t* qb_ = (bf16_t*)(ws + MC_Q); bf16_t* kb = (bf16_t*)(ws + MC_K); bf16_t* vb = (bf16_t*)(ws + MC_V); bf16_t* ob = (bf16_t*)(ws + MC_O);
    norm_rows<false>(F, h, G(P.attn_norm) + 2 * DM, hn);
    GRID_BAR();
    run_gemm<pg8::EpiBf16, pg8::BMapPerm>(F, hn, DM, (const bf16_t*)(ws + WC_DOWN), DM, DM, C_DOWNP, pg8::EpiBf16{cd, C_DOWNP});
    GRID_BAR();
    c_mid(F, P);
    GRID_BAR();
    run_gemm<pg8::EpiRope<SelUq>, pg8::BMapPerm>(F, cqn, 512, (const bf16_t*)(ws + WC_UQ), 512, 512, C_UQ, pg8::EpiRope<SelUq>{qb_, C_UQ, (const f32x2*)(ws + WS_CS), nullptr});
    run_gemm<pg8::EpiUkv, pg8::BMapPerm>(F, ckvn, 512, (const bf16_t*)(ws + WC_UKV), 512, 512, C_UKV, pg8::EpiUkv{kb, vb});
    GRID_BAR();
    {
        const int vcu = vcu_of(F); LAS char* lds = (LAS char*)F.lds;
        const float c2 = 0.07216878364870322f * LOG2E;
        for (int rep_ = 0; rep_ < REP_MLA; ++rep_)
        for (int it = vcu; it < 256; it += F.G) {
            const int head = it >> 4, x = it & 15;
#pragma unroll 1
            for (int pass = 0; pass < 2; ++pass) { const int qb = pass ? 31 - x : x;
                fa::attn_block<192, 128, false>(lds, F.wave, qb_ + (size_t)qb * 256 * 3072 + head * 192, 3072, kb + head * 192, 3072, vb + head * 128, 2048,
                                                ob + (size_t)qb * 256 * DM + head * 128, DM, 4 * qb, 1 << 20, c2, G(P.pos)); }
        }
    }
    GRID_BAR();
    run_gemm<pg8::EpiResid, pg8::BMapPlain>(F, ob, DM, (const bf16_t*)(ws + WC_OUT), DM, DM, DM, pg8::EpiResid{h, h, DM});
    GRID_BAR();
}
struct SelAin { static __device__ __forceinline__ bool tile_any(int pn) { return pn >= 12; }
                static __device__ __forceinline__ int j0(int col0) { return (col0 >= AQI_OFF && col0 < AWI_OFF && (col0 & 127) < 64) ? ((col0 & 127) >> 1) : -1; } };
namespace pg8 {
struct IdxOrder {
    int G, c;
    static constexpr int NUNITS = 8448;
    __device__ bool next(int i, Unit& u) const {
        const int L = i * G + c; if (L >= NUNITS) return false;
        int g = 0;
#pragma unroll
        for (int bstep = 16; bstep >= 1; bstep >>= 1) if (8 * (g + bstep) * (g + bstep + 1) <= L) g += bstep;
        const int rem = L - 8 * g * (g + 1); u.pn = 16 * g + rem / (g + 1); u.pm = rem % (g + 1); u.seq = i; return true;
    }
    __device__ __forceinline__ long a_off(const Unit& u, int lda) const { return (long)u.pm * BM * lda; }
    __device__ __forceinline__ long b_off(const Unit& u, int ldb) const { return (long)u.pn * 16 * ldb; }
};
struct BMapIdx { static __device__ __forceinline__ long off(int h, int R, int ldb) { const int ql = 4 * (R >> 5) + ((R >> 2) & 3), hd = 8 * h + 4 * ((R >> 4) & 1) + (R & 3); return (long)ql * ldb + hd * 128; } };
struct EpiIdx {
    const bf16_t* wi; int ldw; bf16_t* SC; LAS char* stg;
    __device__ __forceinline__ void pre(const Unit& u, int wave, int lane) const {
        if (wave == 0) __builtin_amdgcn_global_load_lds((const unsigned*)(wi + (size_t)(u.pn * 16 + ((lane & 31) >> 1)) * ldw + (lane & 1) * 8), (LAS unsigned*)(stg + 8192 + (u.seq & 1) * 1024), 16, 0, 0); }
    __device__ __forceinline__ void operator()(const f32x4 (&acc)[2][2][4][2], const Unit& u, int wr, int wc, int fr_, int fq) const {
        int fr = fr_; asm volatile("" : "+v"(fr));
        const LAS u32x4* wl = (const LAS u32x4*)(stg + 8192 + (u.seq & 1) * 1024 + (4 * wc + fq) * 32); const u32x4 w0 = wl[0], w1 = wl[1];
        const float wv[16] = {bf_lo(w0.x), bf_hi(w0.x), bf_lo(w0.y), bf_hi(w0.y), bf_lo(w0.z), bf_hi(w0.z), bf_lo(w0.w), bf_hi(w0.w),
                              bf_lo(w1.x), bf_hi(w1.x), bf_lo(w1.y), bf_hi(w1.y), bf_lo(w1.z), bf_hi(w1.z), bf_lo(w1.w), bf_hi(w1.w)};
        LAS unsigned short* srow = (LAS unsigned short*)stg + (4 * wc + fq) * 256 + wr * 64 + fr;
#pragma unroll
        for (int ai = 0; ai < 2; ++ai)
#pragma unroll
            for (int m = 0; m < 4; ++m) { float s = 0.f;
#pragma unroll
                for (int bj = 0; bj < 2; ++bj)
#pragma unroll
                    for (int n = 0; n < 2; ++n)
#pragma unroll
                        for (int e = 0; e < 4; ++e) s = fmaf(wv[8 * bj + 4 * n + e], fmaxf(acc[ai][bj][m][n][e], 0.f), s);
                srow[ai * HALF + m * 16] = (unsigned short)f2bf(s); }
        asm volatile("s_waitcnt lgkmcnt(0)" ::: "memory"); __builtin_amdgcn_s_barrier(); asm volatile("" ::: "memory");
        const int tid = (wr * 4 + wc) * 64 + fq * 16 + fr, r = tid >> 5, ch = tid & 31;
        const u32x4 v = *(const LAS u32x4*)(stg + r * 512 + ch * 16);
        *(u32x4*)(SC + (size_t)(u.pn * 16 + r) * SEQ + u.pm * BM + ch * 8) = v;
    }
};
}

__device__ __forceinline__ unsigned fkey(float x) { const unsigned u = __float_as_uint(x); return u ^ ((u >> 31) ? 0xFFFFFFFFu : 0x80000000u); }
__device__ __forceinline__ void topk_rows(const Frame& F, const float* SC, int* IDX) {
    const int lane = lane_id();
    LAS unsigned* hist = (LAS unsigned*)(F.lds + F.wave * 1024);
    const unsigned long long ltmask = (1ull << lane) - 1ull;
    for (int q = F.gw; q < SEQ; q += F.NGW) {
        const int n = 64 * ((q >> 6) + 1);
        int* out = IDX + (size_t)q * TOPK;
        if (n <= TOPK) { for (int i = lane; i < TOPK; i += 64) out[i] = i < n ? i : -1; continue; }
        const float* row = SC + (size_t)q * SEQ;
        unsigned prefix = 0u; int kneed = TOPK;
#pragma unroll 1
        for (int pass = 0; pass < 4; ++pass) {
            const int shift = 24 - 8 * pass;
            hist[lane] = 0u; hist[lane + 64] = 0u; hist[lane + 128] = 0u; hist[lane + 192] = 0u;
            LDS_WAIT();
            for (int i = lane * 4; i < n; i += 256) { const f32x4 v = *(const f32x4*)(row + i);
#pragma unroll
                for (int e = 0; e < 4; ++e) { const unsigned u = fkey(v[e]);
                    if (pass == 0 || (u >> (shift + 8)) == prefix) __hip_atomic_fetch_add(hist + ((u >> shift) & 255u), 1u, __ATOMIC_RELAXED, __HIP_MEMORY_SCOPE_WORKGROUP); } }
            LDS_WAIT();
            const int c0 = (int)hist[255 - 4 * lane], c1 = (int)hist[254 - 4 * lane], c2 = (int)hist[253 - 4 * lane], c3 = (int)hist[252 - 4 * lane];
            const int s = c0 + c1 + c2 + c3; int incl = s;
#pragma unroll
            for (int o = 1; o < 64; o <<= 1) { const int t = __shfl_up(incl, o); if (lane >= o) incl += t; }
            const int excl = incl - s;
            const bool mine = (excl < kneed) && (kneed <= incl);
            int digit = 0, above = 0;
            if (mine) { int cum = excl;
                if (cum + c0 >= kneed) { digit = 255 - 4 * lane; above = cum; }
                else { cum += c0; if (cum + c1 >= kneed) { digit = 254 - 4 * lane; above = cum; }
                    else { cum += c1; if (cum + c2 >= kneed) { digit = 253 - 4 * lane; above = cum; } else { cum += c2; digit = 252 - 4 * lane; above = cum; } } } }
            const unsigned long long mm = __ballot(mine); const int src = mm ? (int)__builtin_ctzll(mm) : 0;
            digit = __shfl(digit, src); above = __shfl(above, src);
            prefix = (prefix << 8) | (unsigned)digit; kneed -= above;
            LDS_WAIT();
        }
        int base = 0, tbase = 0;
        for (int i0 = 0; i0 < n; i0 += 256) { const int i = i0 + lane * 4; const bool ok = i < n;
            f32x4 v = (f32x4){0.f, 0.f, 0.f, 0.f}; if (ok) v = *(const f32x4*)(row + i);
#pragma unroll
            for (int e = 0; e < 4; ++e) { const unsigned u = fkey(v[e]); const bool gt = ok && u > prefix, eq = ok && u == prefix;
                const unsigned long long me = __ballot(eq);
                const bool sel = gt || (eq && (tbase + (int)__builtin_popcountll(me & ltmask)) < kneed);
                const unsigned long long ms = __ballot(sel);
                if (sel) { const int p = base + (int)__builtin_popcountll(ms & ltmask); if (p < TOPK) out[p] = i + e; }
                base += (int)__builtin_popcountll(ms); tbase += (int)__builtin_popcountll(me); } }
    }
}


__device__ __forceinline__ unsigned skey16(unsigned x) { return x ^ ((x & 0x8000u) ? 0xFFFFu : 0x8000u); }
template <int NV>
__device__ __forceinline__ void topk_row_regs(const bf16_t* row, int n, int* out, LAS unsigned* hist, int lane) {
    const unsigned long long ltmask = (1ull << lane) - 1ull;
    unsigned u[NV][4];
#pragma unroll
    for (int j = 0; j < NV; ++j) { const int i = 8 * (64 * j + lane); const bool ok = i < n; const u32x4 v = *(const u32x4*)(row + (ok ? i : 0));
#pragma unroll
        for (int e = 0; e < 4; ++e) { const unsigned w = v[e]; u[j][e] = ok ? (w ^ ((((w >> 15) & 0x00010001u) * 0x7FFFu) | 0x80008000u)) : 0u; } }
#define TK_KEY(j_, e_) (((e_) & 1) ? (u[j_][(e_) >> 1] >> 16) : (u[j_][(e_) >> 1] & 0xFFFFu))
    unsigned prefix = 0u; int kneed = TOPK;
#pragma unroll 1
    for (int pass = 0; pass < 2; ++pass) {
#pragma unroll
        for (int k = 0; k < 8; ++k) ((LAS u32x4*)hist)[lane + 64 * k] = (u32x4){0u, 0u, 0u, 0u};
        LDS_WAIT();
#pragma unroll
        for (int j = 0; j < NV; ++j)
#pragma unroll
            for (int e = 0; e < 8; ++e) { const unsigned x = TK_KEY(j, e); const bool m = pass == 0 ? (x != 0u) : ((x >> 5) == prefix);
                if (m) __hip_atomic_fetch_add(hist + (pass == 0 ? (x >> 5) : (x & 31u)), 1u, __ATOMIC_RELAXED, __HIP_MEMORY_SCOPE_WORKGROUP); }
        LDS_WAIT();
        int s = 0;
#pragma unroll
        for (int k = 0; k < 8; ++k) { const u32x4 w = ((const LAS u32x4*)(hist + 2016 - 32 * lane))[k]; s += (int)((w.x + w.y) + (w.z + w.w)); }
        int incl = s;
#pragma unroll
        for (int o = 1; o < 64; o <<= 1) { const int t = __shfl_up(incl, o); if (lane >= o) incl += t; }
        const int excl = incl - s;
        const unsigned long long m1 = __ballot(excl < kneed && kneed <= incl); const int L1 = m1 ? (int)__builtin_ctzll(m1) : 0;
        const int exclL = __shfl(excl, L1);
        const int c = lane < 32 ? (int)hist[2047 - 32 * L1 - lane] : 0; int incl2 = c;
#pragma unroll
        for (int o = 1; o < 64; o <<= 1) { const int t = __shfl_up(incl2, o); if (lane >= o) incl2 += t; }
        const int excl2 = incl2 - c;
        const unsigned long long m2 = __ballot(exclL + excl2 < kneed && kneed <= exclL + incl2); const int L2 = m2 ? (int)__builtin_ctzll(m2) : 0;
        const unsigned digit = (unsigned)(2047 - 32 * L1 - L2);
        kneed -= exclL + __shfl(excl2, L2);
        prefix = pass == 0 ? digit : ((prefix << 5) | digit);
        LDS_WAIT();
    }
    int base = 0;
#pragma unroll
    for (int j = 0; j < NV; ++j)
#pragma unroll
        for (int e = 0; e < 8; ++e) { const bool gt = TK_KEY(j, e) > prefix; const unsigned long long mg = __ballot(gt);
            if (mg) { if (gt) out[base + (int)__builtin_popcountll(mg & ltmask)] = 8 * (64 * j + lane) + e; base += (int)__builtin_popcountll(mg); } }
#pragma unroll
    for (int j = 0; j < NV; ++j)
#pragma unroll
        for (int e = 0; e < 8; ++e) { const bool eq = TK_KEY(j, e) == prefix; const unsigned long long me = __ballot(eq);
            if (me) { if (eq) { const int p = base + (int)__builtin_popcountll(me & ltmask); if (p < TOPK) out[p] = 8 * (64 * j + lane) + e; } base += (int)__builtin_popcountll(me); } }
#undef TK_KEY
}
__device__ __forceinline__ void topk_rows2(const Frame& F, const bf16_t* SC, int* IDX, const int only = -1) {
    const int lane = lane_id();
    LAS unsigned* hist = (LAS unsigned*)(F.lds + F.wave * (only >= 0 ? 13824 : 16384));
    int ri_ = -1;
    for (int q = F.gw; q < SEQ; q += F.NGW) {
        ++ri_; if (only >= 0 && ri_ != only) continue;
        const int n = 64 * ((q >> 6) + 1);
        int* out = IDX + (size_t)q * TOPK;
        if (n <= TOPK) { for (int i = lane; i < TOPK; i += 64) out[i] = i < n ? i : -1; continue; }
        const bf16_t* row = SC + (size_t)q * SEQ;
        if (n <= 2048) topk_row_regs<4>(row, n, out, hist, lane);
        else if (n <= 4096) topk_row_regs<8>(row, n, out, hist, lane);
        else if (n <= 6144) topk_row_regs<12>(row, n, out, hist, lane);
        else topk_row_regs<16>(row, n, out, hist, lane);
    }
}

__device__ __forceinline__ int t5_bucket(int rel) {
    const int n = rel < 0 ? -rel : rel; int b = rel > 0 ? 16 : 0;
    if (n < 8) return b + n;
    int large = 8 + (int)(__log2f((float)n * 0.125f) * (8.0f / 7.0f)); large = large > 15 ? 15 : large;
    return b + large;
}
__device__ __forceinline__ void sparse_attn(const Frame& F, KP P, const bf16_t* qkvi, const int* IDX, bf16_t* O) {
    const int lane = lane_id(), g = lane >> 4, c = lane & 15;
    LAS float* lg = (LAS float*)(F.lds + F.wave * 16384);
    LAS float* t5l = (LAS float*)(F.lds + MISC_OFF + 1024);
    __syncthreads();
    { const int tid = F.wave * 64 + lane; t5l[tid] = G(P.t5)[tid]; }
    __syncthreads();
    const float scale = 0.08838834764831845f;
    for (int q = F.gw; q < SEQ; q += F.NGW) {
        const int pq = G(P.pos)[q];
        float qf[4][8];
#pragma unroll
        for (int e = 0; e < 4; ++e) { const u32x4 w = *(const u32x4*)(qkvi + (size_t)q * A_INP + AQ_OFF + (4 * g + e) * 128 + 8 * c);
            qf[e][0] = bf_lo(w.x) * scale; qf[e][1] = bf_hi(w.x) * scale; qf[e][2] = bf_lo(w.y) * scale; qf[e][3] = bf_hi(w.y) * scale;
            qf[e][4] = bf_lo(w.z) * scale; qf[e][5] = bf_hi(w.z) * scale; qf[e][6] = bf_lo(w.w) * scale; qf[e][7] = bf_hi(w.w) * scale; }
        int id[4];
#pragma unroll
        for (int kk = 0; kk < 4; ++kk) id[kk] = IDX[(size_t)q * TOPK + kk * 64 + lane];
#pragma unroll
        for (int kk = 0; kk < 4; ++kk) {
#pragma unroll 4
            for (int i = 0; i < 64; ++i) {
                const int kidx = __builtin_amdgcn_readlane(id[kk], i); const int key = kk * 64 + i;
                if (kidx < 0) { if (c == 0) {
#pragma unroll
                        for (int e = 0; e < 4; ++e) lg[(4 * g + e) * 256 + key] = -__builtin_inff(); }
                    continue; }
                const u32x4 w = *(const u32x4*)(qkvi + (size_t)kidx * A_INP + AK_OFF + g * 128 + 8 * c);
                const float kf[8] = {bf_lo(w.x), bf_hi(w.x), bf_lo(w.y), bf_hi(w.y), bf_lo(w.z), bf_hi(w.z), bf_lo(w.w), bf_hi(w.w)};
                float pr[4];
#pragma unroll
                for (int e = 0; e < 4; ++e) { float s = 0.f;
#pragma unroll
                    for (int j = 0; j < 8; ++j) s = fmaf(qf[e][j], kf[j], s);
                    s += __shfl_xor(s, 1); s += __shfl_xor(s, 2); s += __shfl_xor(s, 4); s += __shfl_xor(s, 8); pr[e] = s; }
                const int bk = t5_bucket(G(P.pos)[kidx] - pq);
                if (c == 0) {
#pragma unroll
                    for (int e = 0; e < 4; ++e) lg[(4 * g + e) * 256 + key] = pr[e] + t5l[bk * 16 + 4 * g + e]; }
            }
        }
        LDS_WAIT();
#pragma unroll 1
        for (int hd = 0; hd < 16; ++hd) {
            const float x0 = lg[hd * 256 + lane], x1 = lg[hd * 256 + 64 + lane], x2 = lg[hd * 256 + 128 + lane], x3 = lg[hd * 256 + 192 + lane];
            const float m = wave_max(fmaxf(fmaxf(x0, x1), fmaxf(x2, x3)));
            const float e0 = __expf(x0 - m), e1 = __expf(x1 - m), e2 = __expf(x2 - m), e3 = __expf(x3 - m);
            const float inv = 1.0f / wave_sum((e0 + e1) + (e2 + e3));
            lg[hd * 256 + lane] = e0 * inv; lg[hd * 256 + 64 + lane] = e1 * inv; lg[hd * 256 + 128 + lane] = e2 * inv; lg[hd * 256 + 192 + lane] = e3 * inv;
        }
        LDS_WAIT();
        float acc[4][8];
#pragma unroll
        for (int e = 0; e < 4; ++e)
#pragma unroll
            for (int j = 0; j < 8; ++j) acc[e][j] = 0.f;
#pragma unroll
        for (int kk = 0; kk < 4; ++kk) {
#pragma unroll 4
            for (int i = 0; i < 64; ++i) {
                const int kidx = __builtin_amdgcn_readlane(id[kk], i); const int key = kk * 64 + i;
                if (kidx < 0) continue;
                const u32x4 w = *(const u32x4*)(qkvi + (size_t)kidx * A_INP + AV_OFF + g * 128 + 8 * c);
                const float vf[8] = {bf_lo(w.x), bf_hi(w.x), bf_lo(w.y), bf_hi(w.y), bf_lo(w.z), bf_hi(w.z), bf_lo(w.w), bf_hi(w.w)};
#pragma unroll
                for (int e = 0; e < 4; ++e) { const float p = lg[(4 * g + e) * 256 + key];
#pragma unroll
                    for (int j = 0; j < 8; ++j) acc[e][j] = fmaf(p, vf[j], acc[e][j]); }
            }
        }
#pragma unroll
        for (int e = 0; e < 4; ++e) { u32x4 w; w.x = pk2(acc[e][0], acc[e][1]); w.y = pk2(acc[e][2], acc[e][3]); w.z = pk2(acc[e][4], acc[e][5]); w.w = pk2(acc[e][6], acc[e][7]);
            *(u32x4*)(O + (size_t)q * DM + (4 * g + e) * 128 + 8 * c) = w; }
        LDS_WAIT();
    }
}


typedef short s16x4v __attribute__((ext_vector_type(4)));
#define SA_COPY16(g, l) (*(LAS u32x4*)((l) + lane * 16) = *(const u32x4*)(g))
constexpr int SA_VBUF = 4608, SA_RING = 3 * SA_VBUF, SA_AUX_OFF = 8 * SA_RING, SA_AUX = 1280;
__device__ __forceinline__ void sparse_attn2(const Frame& F, KP P, const bf16_t* qkvi, const int* IDX, bf16_t* O) {
    const int lane = lane_id(), hc = lane & 15, rq = lane >> 4;
    LAS char* ring = (LAS char*)F.lds + F.wave * SA_RING;
    LAS int* rowoff = (LAS int*)((LAS char*)F.lds + SA_AUX_OFF + F.wave * SA_AUX);
    LAS unsigned char* bkt = (LAS unsigned char*)(rowoff + 256);
    LAS float* t5l = (LAS float*)((LAS char*)F.lds + MISC_OFF + 1024);
    __syncthreads();
    { const int tid = F.wave * 64 + lane; t5l[tid] = G(P.t5)[tid] * LOG2E; if (tid < 16) t5l[512 + tid] = -__builtin_inff(); }
    __syncthreads();
    const float c2 = 0.08838834764831845f * LOG2E;
    constexpr int LDB = A_INP * 2;
    const int trl = rq * 1152 + ((hc & 3) >> 1) * 64 + (hc >> 2) * 16 + (hc & 1) * 8;
    for (int q = F.gw; q < SEQ; q += F.NGW) {
        const int pq = G(P.pos)[q];
#pragma unroll
        for (int k4 = 0; k4 < 4; ++k4) { const int slot = k4 * 64 + lane; const int kidx = IDX[(size_t)q * TOPK + slot]; const bool ok = kidx >= 0;
            rowoff[slot] = ok ? kidx * LDB : 0; bkt[slot] = (unsigned char)(ok ? t5_bucket(G(P.pos)[ok ? kidx : 0] - pq) : 32); }
        LDS_WAIT();
#pragma unroll 1
        for (int g = 0; g < 4; ++g) {
            bf16x8 qf[4];
#pragma unroll
            for (int kk = 0; kk < 4; ++kk) { qf[kk] = (bf16x8){0, 0, 0, 0, 0, 0, 0, 0};
                if (hc < 4) qf[kk] = *(const bf16x8*)(qkvi + (size_t)q * A_INP + AQ_OFF + (4 * g + hc) * 128 + 32 * kk + 8 * rq); }
            const char* kbase = (const char*)qkvi + (AK_OFF + g * 128) * 2 + rq * 16;
            f32x4 S[16]; bf16x8 kq[4][4];
#pragma unroll
            for (int pt = 0; pt < 4; ++pt)
#pragma unroll
                for (int kk = 0; kk < 4; ++kk) kq[pt][kk] = *(const bf16x8*)(kbase + rowoff[16 * pt + hc] + kk * 64);
#pragma unroll
            for (int t = 0; t < 16; ++t) {
                f32x4 a = (f32x4){0.f, 0.f, 0.f, 0.f};
#pragma unroll
                for (int kk = 0; kk < 4; ++kk) a = __builtin_amdgcn_mfma_f32_16x16x32_bf16(kq[t % 4][kk], qf[kk], a, 0, 0, 0);
                S[t] = a;
                if (t + 4 < 16) {
#pragma unroll
                    for (int kk = 0; kk < 4; ++kk) kq[t % 4][kk] = *(const bf16x8*)(kbase + rowoff[16 * (t + 4) + hc] + kk * 64); } }
            const char* vbase = (const char*)qkvi + (AV_OFF + g * 128) * 2 + (lane >> 2) * 16;
            u32x4 vr[4][4];
#define SA_VLOAD(t) do { _Pragma("unroll") for (int j_ = 0; j_ < 4; ++j_) vr[(t) % 4][j_] = *(const u32x4*)(vbase + rowoff[16 * (t) + 4 * j_ + (lane & 3)]); } while (0)
#define SA_VSTORE(t) do { _Pragma("unroll") for (int j_ = 0; j_ < 4; ++j_) *(LAS u32x4*)(ring + ((t) % 2) * SA_VBUF + j_ * 1152 + lane * 16) = vr[(t) % 4][j_]; } while (0)
            SA_VLOAD(0); SA_VLOAD(1); SA_VLOAD(2); SA_VLOAD(3);
            float m = -__builtin_inff();
#pragma unroll
            for (int t = 0; t < 16; ++t) { const unsigned w = *(const LAS unsigned*)(bkt + 16 * t + 4 * rq);
#pragma unroll
                for (int r = 0; r < 4; ++r) { const int b = (w >> (8 * r)) & 255; S[t][r] = fmaf(S[t][r], c2, t5l[b * 16 + 4 * g + (hc & 3)]); m = fmaxf(m, S[t][r]); } }
            m = fmaxf(m, __shfl_xor(m, 16)); m = fmaxf(m, __shfl_xor(m, 32));
            float l = 0.f; s16x4v pf[16];
#pragma unroll
            for (int t = 0; t < 16; ++t) { float e[4];
#pragma unroll
                for (int r = 0; r < 4; ++r) { e[r] = __builtin_amdgcn_exp2f(S[t][r] - m); l += e[r]; }
                u32x2 w; w.x = cvt_pk_bf16(e[0], e[1]); w.y = cvt_pk_bf16(e[2], e[3]); pf[t] = __builtin_bit_cast(s16x4v, w); }
            l += __shfl_xor(l, 16); l += __shfl_xor(l, 32);
            f32x4 o[8];
#pragma unroll
            for (int dt = 0; dt < 8; ++dt) o[dt] = (f32x4){0.f, 0.f, 0.f, 0.f};
#pragma unroll
            for (int t = 0; t < 16; ++t) {
                SA_VSTORE(t);
                if (t + 4 < 16) SA_VLOAD(t + 4);
                const LAS char* vb = ring + (t % 2) * SA_VBUF + trl;
#pragma unroll
                for (int dt = 0; dt < 8; ++dt) { const s16x4v a = __builtin_bit_cast(s16x4v, __builtin_amdgcn_ds_read_tr16_b64_v4i16((LAS fa::v4i16_t*)(vb + dt * 128)));
                    o[dt] = __builtin_amdgcn_mfma_f32_16x16x16bf16_1k(a, pf[t], o[dt], 0, 0, 0); }
            }
#undef SA_VLOAD
#undef SA_VSTORE
            const float rl = 1.0f / l;
            if (hc < 4) {
#pragma unroll
                for (int dt = 0; dt < 8; ++dt) { u32x2 w; w.x = cvt_pk_bf16(o[dt][0] * rl, o[dt][1] * rl); w.y = cvt_pk_bf16(o[dt][2] * rl, o[dt][3] * rl);
                    *(u32x2*)(O + (size_t)q * DM + (4 * g + hc) * 128 + 16 * dt + 4 * rq) = w; } }
        }
        LDS_WAIT();
    }
}


__device__ __forceinline__ unsigned cvt_pk_bf16_s(float lo, float hi) { unsigned r; asm("v_cvt_pk_bf16_f32 %0, %1, %2" : "=v"(r) : "v"(lo), "v"(hi)); return r; }
__device__ __forceinline__ void sparse_attn3(const Frame& F, KP P, const bf16_t* qkvi, const unsigned char* kv8, const int* IDX, bf16_t* O, const bool hot = false) {
    const int lane = lane_id(), hc = lane & 15, rq = lane >> 4;
    LAS char* ring = (LAS char*)F.lds + F.wave * SA_RING;
    LAS int* rowoff = (LAS int*)((LAS char*)F.lds + SA_AUX_OFF + F.wave * SA_AUX);
    LAS unsigned char* bkt = (LAS unsigned char*)(rowoff + 256);
    LAS float* t5l = (LAS float*)((LAS char*)F.lds + MISC_OFF + 1024);
    __syncthreads();
    { const int tid = F.wave * 64 + lane; t5l[tid] = G(P.t5)[tid] * LOG2E; if (tid < 16) t5l[512 + tid] = -__builtin_inff(); }
    __syncthreads();
    const float c2 = 0.08838834764831845f * LOG2E;
    const int trl = rq * 1152 + ((hc & 3) >> 1) * 64 + (hc >> 2) * 16 + (hc & 1) * 8;
    const int vst = ((lane & 7) >> 2) * 1152 + (2 * (lane >> 3)) * 64 + (lane & 3) * 16;
    const int* pos = G(P.pos);
#define SA_KLOAD(gg, t) do { _Pragma("unroll") for (int L_ = 0; L_ < 2; ++L_) kq[(t) % 6][L_] = *(const u32x4*)(kv8 + (size_t)(gg) * (SEQ * 128) + rq * 16 + rowoff[16 * (t) + hc] + 64 * L_); } while (0)
    for (int q = F.gw; q < SEQ; q += F.NGW) {
        const int pq = pos[q];
#pragma unroll
        for (int k4 = 0; k4 < 4; ++k4) { const int slot = k4 * 64 + lane; const int kidx = IDX[(size_t)q * TOPK + slot]; const bool ok = kidx >= 0;
            rowoff[slot] = ok ? (hot ? (kidx & 255) : kidx) * 128 : 0; bkt[slot] = (unsigned char)(ok ? t5_bucket(pos[ok ? kidx : 0] - pq) : 32); }
        LDS_WAIT();
        u32x4 kq[6][2];
        SA_KLOAD(0, 0); SA_KLOAD(0, 1); SA_KLOAD(0, 2); SA_KLOAD(0, 3); SA_KLOAD(0, 4); SA_KLOAD(0, 5);
#pragma unroll 1
        for (int g = 0; g < 4; ++g) {
            long qf[4];
#pragma unroll
            for (int L = 0; L < 2; ++L) { u32x4 a = (u32x4){0u, 0u, 0u, 0u}, b = (u32x4){0u, 0u, 0u, 0u};
                if (hc < 4) { const bf16_t* qp = qkvi + (size_t)q * A_INP + AQ_OFF + (4 * g + hc) * 128 + 64 * L + 16 * rq; a = *(const u32x4*)qp; b = *(const u32x4*)(qp + 8); }
                int w0 = __builtin_amdgcn_cvt_pk_fp8_f32(bf_lo(a.x), bf_hi(a.x), 0, false); w0 = __builtin_amdgcn_cvt_pk_fp8_f32(bf_lo(a.y), bf_hi(a.y), w0, true);
                int w1 = __builtin_amdgcn_cvt_pk_fp8_f32(bf_lo(a.z), bf_hi(a.z), 0, false); w1 = __builtin_amdgcn_cvt_pk_fp8_f32(bf_lo(a.w), bf_hi(a.w), w1, true);
                int w2 = __builtin_amdgcn_cvt_pk_fp8_f32(bf_lo(b.x), bf_hi(b.x), 0, false); w2 = __builtin_amdgcn_cvt_pk_fp8_f32(bf_lo(b.y), bf_hi(b.y), w2, true);
                int w3 = __builtin_amdgcn_cvt_pk_fp8_f32(bf_lo(b.z), bf_hi(b.z), 0, false); w3 = __builtin_amdgcn_cvt_pk_fp8_f32(bf_lo(b.w), bf_hi(b.w), w3, true);
                qf[2 * L] = (long)(((unsigned long long)(unsigned)w1 << 32) | (unsigned)w0); qf[2 * L + 1] = (long)(((unsigned long long)(unsigned)w3 << 32) | (unsigned)w2); }
            f32x4 S[16];
#pragma unroll
            for (int t = 0; t < 16; ++t) {
                f32x4 a = (f32x4){0.f, 0.f, 0.f, 0.f};
#pragma unroll
                for (int L = 0; L < 2; ++L) { const u32x4 w = kq[t % 6][L];
                    a = __builtin_amdgcn_mfma_f32_16x16x32_fp8_fp8((long)(((unsigned long long)w.y << 32) | w.x), qf[2 * L], a, 0, 0, 0);
                    a = __builtin_amdgcn_mfma_f32_16x16x32_fp8_fp8((long)(((unsigned long long)w.w << 32) | w.z), qf[2 * L + 1], a, 0, 0, 0); }
                S[t] = a;
                if (t + 6 < 16) SA_KLOAD(g, t + 6); }
            const unsigned char* vbase = kv8 + (size_t)(4 + g) * (SEQ * 128) + (lane >> 3) * 16;
            u32x4 vr[6][2];
#define SA_VLOAD(t) do { _Pragma("unroll") for (int j_ = 0; j_ < 2; ++j_) vr[(t) % 6][j_] = *(const u32x4*)(vbase + rowoff[16 * (t) + 8 * j_ + (lane & 7)]); } while (0)
#define SA_CV(w_, lo_, hi_) do { const f32x2 f0_ = __builtin_amdgcn_cvt_pk_f32_fp8((int)(w_), false), f1_ = __builtin_amdgcn_cvt_pk_f32_fp8((int)(w_), true); lo_ = cvt_pk_bf16_s(f0_.x, f0_.y); hi_ = cvt_pk_bf16_s(f1_.x, f1_.y); } while (0)
#define SA_VSTORE(t) do { _Pragma("unroll") for (int j_ = 0; j_ < 2; ++j_) { const u32x4 w_ = vr[(t) % 6][j_]; u32x4 c0_, c1_; \
        SA_CV(w_.x, c0_.x, c0_.y); SA_CV(w_.y, c0_.z, c0_.w); SA_CV(w_.z, c1_.x, c1_.y); SA_CV(w_.w, c1_.z, c1_.w); \
        LAS char* d_ = ring + ((t) % 2) * SA_VBUF + j_ * 2304 + vst; *(LAS u32x4*)d_ = c0_; *(LAS u32x4*)(d_ + 64) = c1_; } } while (0)
            SA_VLOAD(0); SA_VLOAD(1); SA_VLOAD(2); SA_VLOAD(3); SA_VLOAD(4); SA_VLOAD(5);
            float m = -__builtin_inff();
#pragma unroll
            for (int t = 0; t < 16; ++t) { const unsigned w = *(const LAS unsigned*)(bkt + 16 * t + 4 * rq);
#pragma unroll
                for (int r = 0; r < 4; ++r) { const int b = (w >> (8 * r)) & 255; S[t][r] = fmaf(S[t][r], c2, t5l[b * 16 + 4 * g + (hc & 3)]); m = fmaxf(m, S[t][r]); } }
            m = fmaxf(m, __shfl_xor(m, 16)); m = fmaxf(m, __shfl_xor(m, 32));
            float l = 0.f; s16x4v pf[16];
#pragma unroll
            for (int t = 0; t < 16; ++t) { float e[4];
#pragma unroll
                for (int r = 0; r < 4; ++r) { e[r] = __builtin_amdgcn_exp2f(S[t][r] - m); l += e[r]; }
                u32x2 w; w.x = cvt_pk_bf16_s(e[0], e[1]); w.y = cvt_pk_bf16_s(e[2], e[3]); pf[t] = __builtin_bit_cast(s16x4v, w); }
            l += __shfl_xor(l, 16); l += __shfl_xor(l, 32);
            if (g < 3) { SA_KLOAD(g + 1, 0); SA_KLOAD(g + 1, 1); SA_KLOAD(g + 1, 2); SA_KLOAD(g + 1, 3); SA_KLOAD(g + 1, 4); SA_KLOAD(g + 1, 5); }
            f32x4 o[8];
#pragma unroll
            for (int dt = 0; dt < 8; ++dt) o[dt] = (f32x4){0.f, 0.f, 0.f, 0.f};
            SA_VSTORE(0); SA_VLOAD(6);
#pragma unroll
            for (int t = 0; t < 16; ++t) {
                const LAS char* vb = ring + (t % 2) * SA_VBUF + trl;
                s16x4v av[8];
#pragma unroll
                for (int dt = 0; dt < 8; ++dt) av[dt] = __builtin_bit_cast(s16x4v, __builtin_amdgcn_ds_read_tr16_b64_v4i16((LAS fa::v4i16_t*)(vb + dt * 128)));
                __builtin_amdgcn_sched_barrier(0);
                if (t + 1 < 16) SA_VSTORE(t + 1);
                if (t + 7 < 16) SA_VLOAD(t + 7);
                __builtin_amdgcn_sched_barrier(0);
#pragma unroll
                for (int dt = 0; dt < 8; ++dt) o[dt] = __builtin_amdgcn_mfma_f32_16x16x16bf16_1k(av[dt], pf[t], o[dt], 0, 0, 0);
            }
#undef SA_VLOAD
#undef SA_VSTORE
#undef SA_CV
            const float rl = 1.0f / l;
            if (hc < 4) {
#pragma unroll
                for (int dt = 0; dt < 8; ++dt) { u32x2 w; w.x = cvt_pk_bf16_s(o[dt][0] * rl, o[dt][1] * rl); w.y = cvt_pk_bf16_s(o[dt][2] * rl, o[dt][3] * rl);
                    *(u32x2*)(O + (size_t)q * DM + (4 * g + hc) * 128 + 16 * dt + 4 * rq) = w; } }
        }
        LDS_WAIT();
    }
#undef SA_KLOAD
}

#ifndef SA_MAPV
#define SA_MAPV 0
#endif
typedef int v2i32_t __attribute__((ext_vector_type(2)));
__device__ __forceinline__ void sparse_attn4(const Frame& F, KP P, const bf16_t* qkvi, const unsigned char* kv8, const int* IDX, bf16_t* O, const int only = -1) {
    const int lane = lane_id(), hc = lane & 15, rq = lane >> 4;
    LAS char* ring = (LAS char*)F.lds + F.wave * SA_RING;
    LAS int* rowoff = (LAS int*)((LAS char*)F.lds + SA_AUX_OFF + F.wave * SA_AUX);
    LAS unsigned char* bkt = (LAS unsigned char*)(rowoff + 256);
    LAS float* t5l = (LAS float*)((LAS char*)F.lds + MISC_OFF + 1024);
    __syncthreads();
    { const int tid = F.wave * 64 + lane; t5l[tid] = G(P.t5)[tid] * LOG2E; if (tid < 16) t5l[512 + tid] = -__builtin_inff(); }
    __syncthreads();
    const float c2 = 0.08838834764831845f * LOG2E;
#if SA_MAPV == 0
    const int qp_ = hc >> 1, pp_ = hc & 1;
#else
    const int qp_ = hc & 7, pp_ = hc >> 3;
#endif
    const int rho_rd = ((qp_ & 3) | ((rq & 1) << 2)) | ((qp_ >> 2) << 3) | ((rq >> 1) << 4);
    const int trl = rho_rd * 144 + 8 * pp_;
    int vst[4];
#pragma unroll
    for (int jj = 0; jj < 4; ++jj) { const int sl = 8 * jj + (lane >> 3); vst[jj] = ((sl & 7) | ((sl >> 4) << 3) | (((sl >> 3) & 1) << 4)) * 144 + (lane & 7) * 16; }
    const int* pos = G(P.pos);
#define SA_KLOAD(gg, t) do { const unsigned char* kb_ = kv8 + (size_t)(gg) * (SEQ * 128); const unsigned ko_ = (unsigned)rowoff[16 * (t) + hc] + (unsigned)(rq * 16); \
        kq[(t) % 6][0] = *(const u32x4*)(kb_ + ko_); kq[(t) % 6][1] = *(const u32x4*)(kb_ + ko_ + 64u); } while (0)
    int ri_ = -1;
    for (int q = F.gw; q < SEQ; q += F.NGW) {
        ++ri_; if (only >= 0 && ri_ != only) continue;
        const int pq = pos[q];
#pragma unroll
        for (int k4 = 0; k4 < 4; ++k4) { const int slot = k4 * 64 + lane; const int kidx = IDX[(size_t)q * TOPK + slot]; const bool ok = kidx >= 0;
            rowoff[slot] = ok ? kidx * 128 : 0; bkt[slot] = (unsigned char)(ok ? t5_bucket(pos[ok ? kidx : 0] - pq) : 32); }
        LDS_WAIT();
        u32x4 kq[6][2];
        SA_KLOAD(0, 0); SA_KLOAD(0, 1); SA_KLOAD(0, 2); SA_KLOAD(0, 3); SA_KLOAD(0, 4); SA_KLOAD(0, 5);
#pragma unroll 1
        for (int g = 0; g < 4; ++g) {
            long qf[4];
#pragma unroll
            for (int L = 0; L < 2; ++L) { u32x4 a = (u32x4){0u, 0u, 0u, 0u}, b = (u32x4){0u, 0u, 0u, 0u};
                if (hc < 4) { const bf16_t* qp = qkvi + (size_t)q * A_INP + AQ_OFF + (4 * g + hc) * 128 + 64 * L + 16 * rq; a = *(const u32x4*)qp; b = *(const u32x4*)(qp + 8); }
                int w0 = __builtin_amdgcn_cvt_pk_fp8_f32(bf_lo(a.x), bf_hi(a.x), 0, false); w0 = __builtin_amdgcn_cvt_pk_fp8_f32(bf_lo(a.y), bf_hi(a.y), w0, true);
                int w1 = __builtin_amdgcn_cvt_pk_fp8_f32(bf_lo(a.z), bf_hi(a.z), 0, false); w1 = __builtin_amdgcn_cvt_pk_fp8_f32(bf_lo(a.w), bf_hi(a.w), w1, true);
                int w2 = __builtin_amdgcn_cvt_pk_fp8_f32(bf_lo(b.x), bf_hi(b.x), 0, false); w2 = __builtin_amdgcn_cvt_pk_fp8_f32(bf_lo(b.y), bf_hi(b.y), w2, true);
                int w3 = __builtin_amdgcn_cvt_pk_fp8_f32(bf_lo(b.z), bf_hi(b.z), 0, false); w3 = __builtin_amdgcn_cvt_pk_fp8_f32(bf_lo(b.w), bf_hi(b.w), w3, true);
                qf[2 * L] = (long)(((unsigned long long)(unsigned)w1 << 32) | (unsigned)w0); qf[2 * L + 1] = (long)(((unsigned long long)(unsigned)w3 << 32) | (unsigned)w2); }
            f32x4 S[16];
#pragma unroll
            for (int t = 0; t < 16; ++t) {
                f32x4 a = (f32x4){0.f, 0.f, 0.f, 0.f};
#pragma unroll
                for (int L = 0; L < 2; ++L) { const u32x4 w = kq[t % 6][L];
                    a = __builtin_amdgcn_mfma_f32_16x16x32_fp8_fp8((long)(((unsigned long long)w.y << 32) | w.x), qf[2 * L], a, 0, 0, 0);
                    a = __builtin_amdgcn_mfma_f32_16x16x32_fp8_fp8((long)(((unsigned long long)w.w << 32) | w.z), qf[2 * L + 1], a, 0, 0, 0); }
                S[t] = a;
                if (t + 6 < 16) SA_KLOAD(g, t + 6); }
            const unsigned char* vbase = kv8 + (size_t)(4 + g) * (SEQ * 128);
            u32x4 vr[3][4];
#define SA_VLOAD(s_) do { _Pragma("unroll") for (int jj_ = 0; jj_ < 4; ++jj_) vr[(s_) % 3][jj_] = *(const u32x4*)(vbase + ((unsigned)rowoff[32 * (s_) + 8 * jj_ + (lane >> 3)] + (unsigned)((lane & 7) * 16))); } while (0)
#define SA_VSTORE(s_) do { _Pragma("unroll") for (int jj_ = 0; jj_ < 4; ++jj_) *(LAS u32x4*)(ring + ((s_) % 2) * SA_VBUF + vst[jj_]) = vr[(s_) % 3][jj_]; } while (0)
            SA_VLOAD(0); SA_VLOAD(1); SA_VLOAD(2);
            float m = -__builtin_inff();
#pragma unroll
            for (int t = 0; t < 16; ++t) { const unsigned w = *(const LAS unsigned*)(bkt + 16 * t + 4 * rq);
#pragma unroll
                for (int r = 0; r < 4; ++r) { const int b = (w >> (8 * r)) & 255; S[t][r] = fmaf(S[t][r], c2, t5l[b * 16 + 4 * g + (hc & 3)]); m = fmaxf(m, S[t][r]); } }
            m = fmaxf(m, __shfl_xor(m, 16)); m = fmaxf(m, __shfl_xor(m, 32));
            m -= 8.0f;
            float l = 0.f; long pf8[8];
#pragma unroll
            for (int s = 0; s < 8; ++s) { float e[8];
#pragma unroll
                for (int r = 0; r < 4; ++r) { e[r] = __builtin_amdgcn_exp2f(S[2 * s][r] - m); e[4 + r] = __builtin_amdgcn_exp2f(S[2 * s + 1][r] - m); }
                l += ((e[0] + e[1]) + (e[2] + e[3])) + ((e[4] + e[5]) + (e[6] + e[7]));
                int w0 = __builtin_amdgcn_cvt_pk_fp8_f32(e[0], e[1], 0, false); w0 = __builtin_amdgcn_cvt_pk_fp8_f32(e[2], e[3], w0, true);
                int w1 = __builtin_amdgcn_cvt_pk_fp8_f32(e[4], e[5], 0, false); w1 = __builtin_amdgcn_cvt_pk_fp8_f32(e[6], e[7], w1, true);
                pf8[s] = (long)(((unsigned long long)(unsigned)w1 << 32) | (unsigned)w0); }
            l += __shfl_xor(l, 16); l += __shfl_xor(l, 32);
            if (g < 3) { SA_KLOAD(g + 1, 0); SA_KLOAD(g + 1, 1); SA_KLOAD(g + 1, 2); SA_KLOAD(g + 1, 3); SA_KLOAD(g + 1, 4); SA_KLOAD(g + 1, 5); }
            f32x4 o[8];
#pragma unroll
            for (int dt = 0; dt < 8; ++dt) o[dt] = (f32x4){0.f, 0.f, 0.f, 0.f};
            SA_VSTORE(0); SA_VLOAD(3);
#pragma unroll
            for (int s = 0; s < 8; ++s) {
                const LAS char* vb = ring + (s % 2) * SA_VBUF + trl;
                v2i32_t av[8];
#pragma unroll
                for (int dt = 0; dt < 8; ++dt) av[dt] = __builtin_amdgcn_ds_read_tr8_b64_v2i32((LAS v2i32_t*)(vb + dt * 16));
                __builtin_amdgcn_sched_barrier(0);
                if (s + 1 < 8) SA_VSTORE(s + 1);
                if (s + 4 < 8) SA_VLOAD(s + 4);
                __builtin_amdgcn_sched_barrier(0);
#pragma unroll
                for (int dt = 0; dt < 8; ++dt) o[dt] = __builtin_amdgcn_mfma_f32_16x16x32_fp8_fp8((long)(((unsigned long long)(unsigned)av[dt].y << 32) | (unsigned)av[dt].x), pf8[s], o[dt], 0, 0, 0);
            }
#undef SA_VLOAD
#undef SA_VSTORE
            const float rl = 1.0f / l;
            if (hc < 4) {
#pragma unroll
                for (int dt = 0; dt < 8; ++dt) { u32x2 w; w.x = cvt_pk_bf16_s(o[dt][0] * rl, o[dt][1] * rl); w.y = cvt_pk_bf16_s(o[dt][2] * rl, o[dt][3] * rl);
                    *(u32x2*)(O + (size_t)q * DM + (4 * g + hc) * 128 + 16 * dt + 4 * rq) = w; } }
        }
        LDS_WAIT();
    }
#undef SA_KLOAD
}

typedef short s16x2 __attribute__((ext_vector_type(2)));
typedef __bf16 bfv2 __attribute__((ext_vector_type(2)));
__device__ __forceinline__ s16x2 cvt_bf2(float a, float b) { const f32x2 v = {a, b}; return __builtin_bit_cast(s16x2, __builtin_convertvector(v, bfv2)); }
template <int V>
__device__ __forceinline__ void indexer4(const Frame& F, const bf16_t* qkvi, bf16_t* SC) {
    const int lane = lane_id(), j = lane & 15, g = lane >> 4, w = F.wave, qg = w & 3, kh = w >> 2;
    LAS char* lds = (LAS char*)F.lds;
    const char* kib = (const char*)(qkvi + AKI_OFF);
    const int Lp = lane ^ ((lane >> 5) << 1);
    const unsigned dma_lo = (unsigned)(16 * (w >> 2) + (Lp >> 2)) * (unsigned)(A_INP * 2) + (unsigned)((w & 3) * 64 + (Lp & 3) * 16);
    const unsigned fo = (unsigned)(kh * 16384 + ((j * 64 + g * 16) ^ ((j >> 3) << 5)));
    const s16x2 zero2 = {0, 0};
#pragma unroll 1
    for (int x = F.bid; x < 256; x += F.G) {
        const int ns0 = (x >> 3) + 1, ns1 = ((511 - x) >> 3) + 1, NT = ns0 + ns1;
#define IX_DMA(n_) do { const int n2_ = (n_) < NT ? (n_) : NT - 1; const unsigned kn_ = 128u * (unsigned)(n2_ < ns0 ? n2_ : n2_ - ns0); LAS char* sb_ = lds + ((n_) & 3) * 32768 + w * 1024; \
        _Pragma("unroll") for (int i_ = 0; i_ < 4; ++i_) __builtin_amdgcn_global_load_lds((const unsigned*)(kib + (dma_lo + (kn_ + 32u * i_) * (unsigned)(A_INP * 2))), (LAS unsigned*)(sb_ + i_ * 8192), 16, 0, 0); } while (0)
        if (!(V & 2)) { IX_DMA(0); IX_DMA(1); IX_DMA(2); }
        bf16x8 bq[4][4]; u32x2 wown = {0u, 0u}; unsigned sofs = 0u;
#pragma unroll 1
        for (int n = 0; n < NT; ++n) {
            if (n == 0 || n == ns0) {
                const int q0 = 16 * (n == 0 ? x : 511 - x) + 4 * qg;
#pragma unroll
                for (int qi = 0; qi < 4; ++qi)
#pragma unroll
                    for (int kk = 0; kk < 4; ++kk) bq[qi][kk] = *(const bf16x8*)(qkvi + ((unsigned)(q0 + qi) * (unsigned)A_INP + (unsigned)(AQI_OFF + j * 128 + 32 * kk + 8 * g)));
                wown = *(const u32x2*)(qkvi + ((unsigned)(q0 + (j & 3)) * (unsigned)A_INP + (unsigned)(AWI_OFF + 4 * g)));
                sofs = (unsigned)(q0 + (j & 3)) * (unsigned)SEQ + (unsigned)(64 * kh + 16 * (j >> 2) + 4 * g);
                asm volatile("s_waitcnt vmcnt(0)" ::: "memory");
#pragma unroll
                for (int qi = 0; qi < 4; ++qi)
#pragma unroll
                    for (int kk = 0; kk < 4; ++kk) asm volatile("" : "+v"(bq[qi][kk]));
                asm volatile("" : "+v"(wown));
            } else if (!(V & 2)) asm volatile("s_waitcnt vmcnt(11)" ::: "memory");
            if (!(V & 4)) __builtin_amdgcn_s_barrier(); asm volatile("" ::: "memory");
            if (!(V & 2)) IX_DMA(n + 3);
            asm volatile("" ::: "memory");
            const unsigned key0 = 128u * (unsigned)(n < ns0 ? n : n - ns0);
            LAS char* sb = lds + (n & 3) * 32768;
            bf16x8 kf[2][4]; f32x4 acc[2][4]; f32x4 d2q[4];
            const f32x4 zero4 = (f32x4){0.f, 0.f, 0.f, 0.f};
#pragma unroll
            for (int qi = 0; qi < 4; ++qi) d2q[qi] = zero4;
#define IX_EPI(t_, qi_) do { if (V & 1) { d2q[qi_] += acc[(t_) & 1][qi_]; } else { const f32x4 ac_ = acc[(t_) & 1][qi_]; \
                const s16x2 lo_ = __builtin_elementwise_max(cvt_bf2(ac_[0], ac_[1]), zero2), hi_ = __builtin_elementwise_max(cvt_bf2(ac_[2], ac_[3]), zero2); \
                const s16x4 a2_ = {lo_[0], lo_[1], hi_[0], hi_[1]}; const bool on_ = j == 4 * (t_) + (qi_); const u32x2 ws_ = {on_ ? wown.x : 0u, on_ ? wown.y : 0u}; \
                d2q[qi_] = __builtin_amdgcn_mfma_f32_16x16x16bf16_1k(a2_, __builtin_bit_cast(s16x4, ws_), d2q[qi_], 0, 0, 0); } } while (0)
#pragma unroll
            for (int kk = 0; kk < 4; ++kk) kf[0][kk] = *(const LAS bf16x8*)(sb + fo + kk * 1024);
#pragma unroll
            for (int t = 0; t < 4; ++t) {
                if (t < 3) {
#pragma unroll
                    for (int kk = 0; kk < 4; ++kk) kf[(t + 1) & 1][kk] = *(const LAS bf16x8*)(sb + fo + (t + 1) * 4096 + kk * 1024); }
                __builtin_amdgcn_sched_barrier(0);
#pragma unroll
                for (int kk = 0; kk < 4; ++kk) {
#pragma unroll
                    for (int qi = 0; qi < 4; ++qi) acc[t & 1][qi] = __builtin_amdgcn_mfma_f32_16x16x32_bf16(bq[qi][kk], kf[t & 1][kk], kk ? acc[t & 1][qi] : zero4, 0, 0, 0);
                    if (t > 0) IX_EPI(t - 1, kk);
                    __builtin_amdgcn_sched_barrier(0);
                }
            }
#pragma unroll
            for (int qi = 0; qi < 4; ++qi) IX_EPI(3, qi);
#undef IX_EPI
            const f32x4 d2 = (d2q[0] + d2q[1]) + (d2q[2] + d2q[3]);
            const s16x2 o0 = cvt_bf2(d2[0], d2[1]), o1 = cvt_bf2(d2[2], d2[3]);
            u32x2 o; o.x = __builtin_bit_cast(unsigned, o0); o.y = __builtin_bit_cast(unsigned, o1);
            asm volatile("" ::: "memory");
            *(u32x2*)(SC + (sofs + key0)) = o;
            asm volatile("" ::: "memory");
        }
#undef IX_DMA
        asm volatile("s_waitcnt vmcnt(0)" ::: "memory"); __builtin_amdgcn_s_barrier(); asm volatile("" ::: "memory");
    }
}

template <int V>
__device__ __forceinline__ void indexer5(const Frame& F, const bf16_t* qkvi, bf16_t* SC) {
    const int lane = lane_id(), j = lane & 15, g = lane >> 4, w = F.wave, qg = w & 3, kh = w >> 2;
    LAS char* lds = (LAS char*)F.lds;
    const char* kib = (const char*)(qkvi + AKI_OFF);
    const int Lp = lane ^ ((lane >> 5) << 1);
    const unsigned dma_lo = (unsigned)(16 * (w >> 2) + (Lp >> 2)) * (unsigned)(A_INP * 2) + (unsigned)((w & 3) * 64 + (Lp & 3) * 16);
    const unsigned fo = (unsigned)(kh * 32768 + ((j * 64 + g * 16) ^ ((j >> 3) << 5)));
    const s16x2 zero2 = {0, 0};
#pragma unroll 1
    for (int x = F.bid; x < 256; x += F.G) {
        const int ns0 = (x >> 4) + 1, ns1 = ((511 - x) >> 4) + 1, NT = ns0 + ns1;
#define IX_DMA(n_) do { const unsigned kn_ = 256u * (unsigned)((n_) < ns0 ? (n_) : (n_) - ns0); LAS char* sb_ = lds + ((n_) & 1) * 65536 + w * 1024; \
        _Pragma("unroll") for (int i_ = 0; i_ < 8; ++i_) __builtin_amdgcn_global_load_lds((const unsigned*)(kib + (dma_lo + (kn_ + 32u * i_) * (unsigned)(A_INP * 2))), (LAS unsigned*)(sb_ + i_ * 8192), 16, 0, 0); } while (0)
        if (!(V & 2)) IX_DMA(0);
        bf16x8 bq[4][4]; u32x2 wown = {0u, 0u}; unsigned sofs = 0u;
#pragma unroll 1
        for (int n = 0; n < NT; ++n) {
            if (n == 0 || n == ns0) {
                const int q0 = 16 * (n == 0 ? x : 511 - x) + 4 * qg;
#pragma unroll
                for (int qi = 0; qi < 4; ++qi)
#pragma unroll
                    for (int kk = 0; kk < 4; ++kk) bq[qi][kk] = *(const bf16x8*)(qkvi + ((unsigned)(q0 + qi) * (unsigned)A_INP + (unsigned)(AQI_OFF + j * 128 + 32 * kk + 8 * g)));
                wown = *(const u32x2*)(qkvi + ((unsigned)(q0 + (j & 3)) * (unsigned)A_INP + (unsigned)(AWI_OFF + 4 * g)));
                sofs = (unsigned)(q0 + (j & 3)) * (unsigned)SEQ + (unsigned)(128 * kh + 16 * (j >> 2) + 4 * g);
                asm volatile("s_waitcnt vmcnt(0)" ::: "memory");
#pragma unroll
                for (int qi = 0; qi < 4; ++qi)
#pragma unroll
                    for (int kk = 0; kk < 4; ++kk) asm volatile("" : "+v"(bq[qi][kk]));
                asm volatile("" : "+v"(wown));
            } else if (!(V & 2)) asm volatile("s_waitcnt vmcnt(2)" ::: "memory");
            if (!(V & 4)) __builtin_amdgcn_s_barrier(); asm volatile("" ::: "memory");
            if (!(V & 2) && n + 1 < NT) IX_DMA(n + 1);
            asm volatile("" ::: "memory");
            const unsigned key0 = 256u * (unsigned)(n < ns0 ? n : n - ns0);
#pragma unroll 1
            for (int hf = 0; hf < 2; ++hf) {
            LAS char* sb = lds + (n & 1) * 65536 + hf * 16384;
            bf16x8 kf[2][4]; f32x4 acc[2][4]; f32x4 d2q[4];
            const f32x4 zero4 = (f32x4){0.f, 0.f, 0.f, 0.f};
#pragma unroll
            for (int qi = 0; qi < 4; ++qi) d2q[qi] = zero4;
#define IX_EPI(t_, qi_) do { if (V & 1) { d2q[qi_] += acc[(t_) & 1][qi_]; } else { const f32x4 ac_ = acc[(t_) & 1][qi_]; \
                const s16x2 lo_ = __builtin_elementwise_max(cvt_bf2(ac_[0], ac_[1]), zero2), hi_ = __builtin_elementwise_max(cvt_bf2(ac_[2], ac_[3]), zero2); \
                const s16x4 a2_ = {lo_[0], lo_[1], hi_[0], hi_[1]}; const bool on_ = j == 4 * (t_) + (qi_); const u32x2 ws_ = {on_ ? wown.x : 0u, on_ ? wown.y : 0u}; \
                d2q[qi_] = __builtin_amdgcn_mfma_f32_16x16x16bf16_1k(a2_, __builtin_bit_cast(s16x4, ws_), d2q[qi_], 0, 0, 0); } } while (0)
#pragma unroll
            for (int kk = 0; kk < 4; ++kk) kf[0][kk] = *(const LAS bf16x8*)(sb + fo + kk * 1024);
#pragma unroll
            for (int t = 0; t < 4; ++t) {
                if (t < 3) {
#pragma unroll
                    for (int kk = 0; kk < 4; ++kk) kf[(t + 1) & 1][kk] = *(const LAS bf16x8*)(sb + fo + (t + 1) * 4096 + kk * 1024); }
                __builtin_amdgcn_sched_barrier(0);
#pragma unroll
                for (int kk = 0; kk < 4; ++kk) {
                    __builtin_amdgcn_s_setprio(1);
#pragma unroll
                    for (int qi = 0; qi < 4; ++qi) acc[t & 1][qi] = __builtin_amdgcn_mfma_f32_16x16x32_bf16(bq[qi][kk], kf[t & 1][kk], kk ? acc[t & 1][qi] : zero4, 0, 0, 0);
                    __builtin_amdgcn_s_setprio(0);
                    if (t > 0) IX_EPI(t - 1, kk);
                    __builtin_amdgcn_sched_barrier(0);
                }
            }
#pragma unroll
            for (int qi = 0; qi < 4; ++qi) IX_EPI(3, qi);
#undef IX_EPI
            const f32x4 d2 = (d2q[0] + d2q[1]) + (d2q[2] + d2q[3]);
            const s16x2 o0 = cvt_bf2(d2[0], d2[1]), o1 = cvt_bf2(d2[2], d2[3]);
            u32x2 o; o.x = __builtin_bit_cast(unsigned, o0); o.y = __builtin_bit_cast(unsigned, o1);
            asm volatile("" ::: "memory");
            *(u32x2*)(SC + (sofs + key0 + 64u * (unsigned)hf)) = o;
            asm volatile("" ::: "memory");
            }
        }
#undef IX_DMA
        asm volatile("s_waitcnt vmcnt(0)" ::: "memory"); __builtin_amdgcn_s_barrier(); asm volatile("" ::: "memory");
    }
}

template <int J>
__device__ __forceinline__ void mixer_a(const Frame& F, KP P, const XcdBarrier& bar, bool from_x) {
    unsigned char* ws = G(P.ws); constexpr int L = 3 * J;
    float* h = (float*)(ws + WS_H); bf16_t* hn = (bf16_t*)(ws + WS_HN); const float* hsrc = from_x ? G(P.x) : h;
    bf16_t* qkvi = (bf16_t*)(ws + MA_QKVI); bf16_t* sc = (bf16_t*)(ws + MA_SC); int* idx = (int*)(ws + MA_IDX); bf16_t* ob = (bf16_t*)(ws + MA_O);
    const unsigned char* wa = ws + (J ? WA1 : WA0);
    if constexpr (J != 0) { norm_rows<false>(F, hsrc, G(P.attn_norm) + L * DM, hn); GRID_BAR(); }
    run_gemm<pg8::EpiRope<SelAin>, pg8::BMapPerm>(F, hn, DM, (const bf16_t*)wa, DM, DM, A_INP, pg8::EpiRope<SelAin>{qkvi, A_INP, (const f32x2*)(ws + WS_CS), ws + WS_KV8});
    GRID_BAR();
#ifdef IDX_GEMM
    { int kdim = 128; asm volatile("" : "+s"(kdim));
      pg8::Gemm g{qkvi + AKI_OFF, qkvi + AQI_OFF, A_INP, A_INP, kdim}; pg8::IdxOrder S{F.G, F.bid};
      pg8::gemm_phase<pg8::EpiIdx, pg8::IdxOrder, pg8::BMapIdx>(F.lds, F.wave, g, S, pg8::EpiIdx{qkvi + AWI_OFF, A_INP, sc, (LAS char*)F.lds + MISC_OFF + 4096}); }
#else
    indexer5<0>(F, qkvi, sc);
#endif
#ifdef PROBE_IDX2
    __syncthreads();
    indexer5<PROBE_IDX2>(F, qkvi, sc + (64u << 20));
#endif
#ifdef PROBE_IDX2_OLD
    __syncthreads();
    { int kdim = 128; asm volatile("" : "+s"(kdim));
      pg8::Gemm g{qkvi + AKI_OFF, qkvi + AQI_OFF, A_INP, A_INP, kdim}; pg8::IdxOrder S{F.G, F.bid};
      pg8::gemm_phase<pg8::EpiIdx, pg8::IdxOrder, pg8::BMapIdx>(F.lds, F.wave, g, S, pg8::EpiIdx{qkvi + AWI_OFF, A_INP, sc, (LAS char*)F.lds + MISC_OFF + 4096}); }
#endif
    GRID_BAR();
#ifdef MERGE_TS
#pragma unroll 1
    for (int ri = 0; ri < (SEQ + F.NGW - 1) / F.NGW; ++ri) {
        topk_rows2(F, sc, idx, ri);
        asm volatile("s_waitcnt vmcnt(0)" ::: "memory"); __builtin_amdgcn_fence(__ATOMIC_RELEASE, "workgroup"); __builtin_amdgcn_fence(__ATOMIC_ACQUIRE, "workgroup");
        sparse_attn4(F, P, qkvi, ws + WS_KV8, idx, ob, ri);
    }
#else
    for (int rep_ = 0; rep_ < REP_TOPK; ++rep_) topk_rows2(F, sc, idx);
    GRID_BAR();
    for (int rep_ = 0; rep_ < REP_SPARSE; ++rep_) sparse_attn4(F, P, qkvi, ws + WS_KV8, idx, ob);
#endif
#ifdef PROBE_SPARSE2
    sparse_attn3(F, P, qkvi, ws + WS_KV8, idx, (bf16_t*)(ws + MA_SC), PROBE_SPARSE2 == 2);
#endif
    GRID_BAR();
    run_gemm<pg8::EpiResid, pg8::BMapPlain>(F, ob, DM, (const bf16_t*)(wa + W_AIN), DM, DM, DM, pg8::EpiResid{hsrc, h, DM});
    GRID_BAR();
}
#ifndef MIX_A
#define MIX_A 1
#endif
#ifndef MIX_B
#define MIX_B 1
#endif
#ifndef MIX_C
#define MIX_C 1
#endif

template <int L>
__device__ __forceinline__ void ffn_ple(const Frame& F, KP P, const XcdBarrier& bar) {
    unsigned char* ws = G(P.ws); unsigned char* wl = ws + WL0 + (size_t)L * WL_SIZE;
    float* h = (float*)(ws + WS_H); bf16_t* hn = (bf16_t*)(ws + WS_HN); bf16_t* act = (bf16_t*)(ws + WS_ACT); bf16_t* proj = (bf16_t*)(ws + WS_PROJ);
    for (int rep_ = 0; rep_ < REP_NORM; ++rep_) norm_rows<false>(F, h, G(P.ffn_norm) + L * DM, hn);
    GRID_BAR();
    for (int rep_ = 0; rep_ < REP_FFNIN; ++rep_) run_gemm<pg8::EpiSwiGLU, pg8::BMapPerm>(F, hn, DM, (const bf16_t*)(wl + WL_FIN), DM, DM, 2 * FFH, pg8::EpiSwiGLU{act, FFH});
#ifdef PROBE_FFN_NULL
    __syncthreads();
    run_gemm<pg8::EpiNull, pg8::BMapPerm>(F, hn, DM, (const bf16_t*)(wl + WL_FIN), DM, DM, 2 * FFH, pg8::EpiNull{(float*)(ws + WS_PROJ)});
#endif
#ifdef PROBE_FFN_DUP
    __syncthreads();
    run_gemm<pg8::EpiSwiGLU, pg8::BMapPerm>(F, hn, DM, (const bf16_t*)(wl + WL_FIN), DM, DM, 2 * FFH, pg8::EpiSwiGLU{act, FFH});
#endif
    { pg8::Gemm g{(const bf16_t*)(ws + WS_PB) + (size_t)L * SEQ * PLE, (const bf16_t*)(wl + WL_PROJ), PLE, PLE, PLE}; pg8::UpperHalfOrder S; S.init(SEQ, DM, F.G, F.bid);
      pg8::gemm_phase<pg8::EpiBf16, pg8::UpperHalfOrder, pg8::BMapPerm>(F.lds, F.wave, g, S, pg8::EpiBf16{proj, DM}); }
    GRID_BAR();
    run_gemm<pg8::EpiResid, pg8::BMapPlain>(F, act, FFH, (const bf16_t*)(wl + WL_FOUT), FFH, FFH, DM, pg8::EpiResid{h, h, DM});
    GRID_BAR();
    norm_rows<false>(F, h, G(P.ple_norm) + L * DM, hn);
    GRID_BAR();
    run_gemm<pg8::EpiPLE, pg8::BMapPlain>(F, hn, DM, (const bf16_t*)(wl + WL_GATE), DM, DM, DM, pg8::EpiPLE{h, proj, DM});
    GRID_BAR();
}
__device__ __forceinline__ void copy_rows(const Frame& F, const float* src, float* dst) {
    const int gt = F.bid * NTHREADS + F.wave * 64 + lane_id(), NT = F.G * NTHREADS;
    for (int i = gt; i < SEQ * DM / 4; i += NT) ((f32x4*)dst)[i] = ((const f32x4*)src)[i];
}

__global__ void __launch_bounds__(NTHREADS, 2) mega_fwd(Params Parg) {
    extern __shared__ __attribute__((aligned(16))) unsigned char lds_raw[];
    Frame F;
    F.lds = (LAS unsigned char*)lds_raw;
    F.wave = __builtin_amdgcn_readfirstlane((int)threadIdx.x >> 6);
    F.G = gridDim.x; F.bid = blockIdx.x; F.gw = F.bid * NWAVES + F.wave; F.NGW = F.G * NWAVES;
    volatile LAS unsigned* MISC = (volatile LAS unsigned*)(F.lds + MISC_OFF);
#ifdef PROBE_ZERO_LDS
    for (int i_ = threadIdx.x; i_ < LDS_BYTES / 4; i_ += NTHREADS) ((LAS unsigned*)F.lds)[i_] = 0u;
    __syncthreads();
#endif
    if (threadIdx.x < 64) MISC[threadIdx.x] = 0u;
    __syncthreads();
    unsigned* ctl = (unsigned*)(G(kparams()->ws) + WS_CTL);
    XcdBarrier bar = xcd_barrier_post(ctl + CW_BAR, MISC + 8, F.wave);

    for (int rep_ = 0; rep_ < REP_PRO; ++rep_) p0_prologue(F, *kparams());
#if MIX_A
    { KP P = *kparams(); norm_rows<false>(F, G(P.x), G(P.attn_norm), (bf16_t*)(G(P.ws) + WS_HN)); }
#endif
    GRID_BAR();
#if MIX_A
    mixer_a<0>(F, *kparams(), bar, true);
#else
    copy_rows(F, G(kparams()->x), (float*)(G(kparams()->ws) + WS_H)); GRID_BAR();
#endif
    ffn_ple<0>(F, *kparams(), bar);
#if MIX_B
    mixer_b(F, *kparams(), bar);
#endif
    ffn_ple<1>(F, *kparams(), bar);
#if MIX_C
    mixer_c(F, *kparams(), bar);
#endif
    ffn_ple<2>(F, *kparams(), bar);
#if MIX_A
    mixer_a<1>(F, *kparams(), bar, false);
#endif
    ffn_ple<3>(F, *kparams(), bar);
    { KP P = *kparams(); norm_rows<true>(F, (const float*)(G(P.ws) + WS_H), G(P.final_norm), G(P.out)); }
}

extern "C" void kernel_launch(void* const* d_in, const int* in_sizes, int n_in, void* d_out, int out_size, void* d_ws, size_t ws_size, hipStream_t stream) {
    static int grid = 0;
    if (grid == 0) {
        if (n_in != 23 || in_sizes[0] != SEQ * DM || out_size != SEQ * DM || ws_size < WS_END) {
            fprintf(stderr, "kernel_launch: unexpected shapes (n_in %d, in0 %d, out %d, ws %zu < %zu); nothing launched\n", n_in, n_in > 0 ? in_sizes[0] : -1, out_size, ws_size, (size_t)WS_END); grid = -1; return; }
        int dev = 0, cus = 0, per_cu = 0;
        if (hipGetDevice(&dev) != hipSuccess || hipDeviceGetAttribute(&cus, hipDeviceAttributeMultiprocessorCount, dev) != hipSuccess) { grid = -1; return; }
        if (hipFuncSetAttribute((const void*)mega_fwd, hipFuncAttributeMaxDynamicSharedMemorySize, LDS_BYTES) != hipSuccess) { fprintf(stderr, "kernel_launch: hipFuncSetAttribute failed\n"); grid = -1; return; }
        if (hipOccupancyMaxActiveBlocksPerMultiprocessor(&per_cu, (const void*)mega_fwd, NTHREADS, LDS_BYTES) != hipSuccess || per_cu < 1)
            fprintf(stderr, "kernel_launch: note: occupancy query reports %d workgroups per CU\n", per_cu);
        (void)hipGetLastError();
        grid = cus;
    }
    if (grid < 0) return;
    if (hipMemsetAsync((char*)d_ws + WS_CTL, 0, CTL_ZERO_BYTES, stream) != hipSuccess) { fprintf(stderr, "kernel_launch: memset failed\n"); return; }
    Params p{};
    p.x = (const float*)d_in[0]; p.p = (const float*)d_in[1]; p.pos = (const int*)d_in[2]; p.t5 = (const float*)d_in[3];
    p.a_w_in = (const float*)d_in[4]; p.a_w_out = (const float*)d_in[5]; p.b_w_in = (const float*)d_in[6]; p.b_rel = (const float*)d_in[7]; p.b_w_out = (const float*)d_in[8];
    p.c_w_down = (const float*)d_in[9]; p.c_qn = (const float*)d_in[10]; p.c_kvn = (const float*)d_in[11]; p.c_w_uq = (const float*)d_in[12]; p.c_w_ukv = (const float*)d_in[13]; p.c_w_out = (const float*)d_in[14];
    p.attn_norm = (const float*)d_in[15]; p.ffn_norm = (const float*)d_in[16]; p.ffn_w_in = (const float*)d_in[17]; p.ffn_w_out = (const float*)d_in[18];
    p.ple_norm = (const float*)d_in[19]; p.ple_w_gate = (const float*)d_in[20]; p.ple_w_proj = (const float*)d_in[21]; p.final_norm = (const float*)d_in[22];
    p.out = (float*)d_out; p.ws = (unsigned char*)d_ws;
    hipLaunchKernelGGL(mega_fwd, dim3(grid), dim3(NTHREADS), LDS_BYTES, stream, p);
    const hipError_t le = hipPeekAtLastError();
    if (le != hipSuccess) fprintf(stderr, "kernel_launch: launch failed: %s\n", hipGetErrorName(le));
}
```

```cpp
#include <hip/hip_runtime.h>
#include <cstdio>
#include <cstdint>

#define GAS __attribute__((address_space(1)))
#define LAS __attribute__((address_space(3)))
typedef unsigned short bf16_t;
typedef short bf16x8 __attribute__((ext_vector_type(8)));
typedef short s16x4 __attribute__((ext_vector_type(4)));
typedef float f32x2 __attribute__((ext_vector_type(2)));
typedef float f32x4 __attribute__((ext_vector_type(4)));
typedef float f32x16 __attribute__((ext_vector_type(16)));
typedef unsigned u32x2 __attribute__((ext_vector_type(2)));
typedef unsigned u32x4 __attribute__((ext_vector_type(4)));

constexpr int SEQ = 8192, DM = 2048, FFH = 5632, PLE = 256, DEPTH = 4;
constexpr float EPS = 1e-6f;
constexpr float LOG2E = 1.4426950408889634f;
constexpr int A_IN = 5264, A_INP = 5376;
constexpr int AQ_OFF = 0, AK_OFF = 2048, AV_OFF = 2560, AQI_OFF = 3072, AKI_OFF = 5120, AWI_OFF = 5248;
constexpr int TOPK = 256;
constexpr int B_IN = 6144;
constexpr int C_DOWN = 1088, C_DOWNP = 1280, C_UQ = 3072, C_UKV = 4096;

constexpr size_t MiB = 1u << 20;
constexpr size_t WS_CTL = 0, CTL_ZERO_BYTES = 32768;
constexpr size_t WS_CS = 1 * MiB;
constexpr size_t WS_H = 4 * MiB;
constexpr size_t WS_HN = 68 * MiB;
constexpr size_t WS_ACT = 100 * MiB;
constexpr size_t WS_PROJ = 188 * MiB;
constexpr size_t WS_PB = 220 * MiB;
constexpr size_t WS_MIX = 236 * MiB;
constexpr size_t MA_QKVI = WS_MIX, MA_SC = WS_MIX + 84 * MiB, MA_IDX = WS_MIX + 340 * MiB, MA_O = WS_MIX + 348 * MiB;
constexpr size_t MB_QKV = WS_MIX, MB_O = WS_MIX + 96 * MiB;
constexpr size_t MC_CD = WS_MIX, MC_CQN = WS_MIX + 20 * MiB, MC_CKVN = WS_MIX + 28 * MiB, MC_Q = WS_MIX + 36 * MiB, MC_K = WS_MIX + 84 * MiB,
                 MC_V = WS_MIX + 132 * MiB, MC_O = WS_MIX + 164 * MiB;
constexpr size_t WS_W = 620 * MiB;
constexpr size_t W_AIN = 21 * MiB, W_AOUT = 8 * MiB, W_A = W_AIN + W_AOUT;
constexpr size_t WA0 = WS_W, WA1 = WS_W + W_A;
constexpr size_t WB_IN = WS_W + 2 * W_A, WB_OUT = WB_IN + 24 * MiB;
constexpr size_t WC_DOWN = WB_OUT + 8 * MiB, WC_UQ = WC_DOWN + 5 * MiB, WC_UKV = WC_UQ + 3 * MiB, WC_OUT = WC_UKV + 4 * MiB;
constexpr size_t WL0 = WC_OUT + 8 * MiB;
constexpr size_t WL_FIN = 0, WL_FOUT = 44 * MiB, WL_GATE = 66 * MiB, WL_PROJ = 74 * MiB, WL_SIZE = 75 * MiB;
constexpr size_t WS_KV8 = WL0 + 4 * WL_SIZE;
constexpr size_t WS_END = WS_KV8 + 8 * MiB;

constexpr int CW_BAR = 4096;

constexpr int RING_BYTES = 131072;
constexpr int MISC_OFF = RING_BYTES;
constexpr int LDS_BYTES = 147456;
constexpr int NWAVES = 8, NTHREADS = 512;

#define LDS_WAIT() asm volatile("s_waitcnt lgkmcnt(0)" ::: "memory")
#define VM_WAIT() asm volatile("s_waitcnt vmcnt(0)" ::: "memory")

__device__ __forceinline__ unsigned f2bf(float f) { unsigned u = __builtin_bit_cast(unsigned, f); return (u + 0x7fffu + ((u >> 16) & 1u)) >> 16; }
__device__ __forceinline__ unsigned pk2(float lo, float hi) { return f2bf(lo) | (f2bf(hi) << 16); }
__device__ __forceinline__ unsigned cvt_pk_bf16(float lo, float hi) { unsigned r; asm volatile("v_cvt_pk_bf16_f32 %0, %1, %2" : "=v"(r) : "v"(lo), "v"(hi)); return r; }
__device__ __forceinline__ float bf_lo(unsigned w) { return __builtin_bit_cast(float, w << 16); }
__device__ __forceinline__ float bf_hi(unsigned w) { return __builtin_bit_cast(float, w & 0xffff0000u); }
__device__ __forceinline__ int lane_id() { int l; asm volatile("v_mbcnt_lo_u32_b32 %0, -1, 0\n\tv_mbcnt_hi_u32_b32 %0, -1, %0" : "=v"(l)); return l; }
__device__ __forceinline__ float wave_sum(float v) {
#pragma unroll
    for (int o = 1; o < 64; o <<= 1) v += __shfl_xor(v, o);
    return v;
}
__device__ __forceinline__ float wave_max(float v) {
#pragma unroll
    for (int o = 1; o < 64; o <<= 1) v = fmaxf(v, __shfl_xor(v, o));
    return v;
}

#define XB_TMO      128
#define XB_XCNT(j)  (256  + 64 * (j))
#define XB_XSUB(j)  (1280 + 64 * (j))
#define XB_XGEN(j)  (2304 + 64 * (j))
#define XB_TOP      3328
#define XB_TOPGEN   3392
#define XCD_BAR_WORDS 3456
#define XB_SPIN_CAP (1u << 20)

__device__ __forceinline__ unsigned xb_ld(unsigned* p)              { return __hip_atomic_load(p, __ATOMIC_RELAXED, __HIP_MEMORY_SCOPE_AGENT); }
__device__ __forceinline__ unsigned xb_add(unsigned* p, unsigned v) { return __hip_atomic_fetch_add(p, v, __ATOMIC_RELAXED, __HIP_MEMORY_SCOPE_AGENT); }
__device__ __forceinline__ unsigned xb_xcc_id() { return (unsigned)__builtin_amdgcn_s_getreg((3 << 11) | 20) & 0xFu; }
#define XB_SPIN(cond, bar) do { unsigned _sp = 0; while (cond) { __builtin_amdgcn_s_sleep(1); \
    if ((++_sp & 255u) == 0u) { if (xb_ld(&(bar)[XB_TMO])) break; if (_sp > XB_SPIN_CAP) { atomicAdd(&(bar)[XB_TMO], 1u); break; } } } } while (0)

struct XcdBarrier { unsigned* bar; unsigned x; volatile LAS unsigned* st; int wave; };

__device__ __forceinline__ XcdBarrier xcd_barrier_post(unsigned* bar, volatile LAS unsigned* st, int wave) {
    XcdBarrier b; b.bar = bar; b.x = xb_xcc_id(); b.st = st; b.wave = wave;
    if (wave == 0 && lane_id() == 0) { const unsigned rank = xb_add(&bar[XB_XCNT(b.x)], 1u); st[2] = rank; st[3] = b.x; }
    return b;
}
__device__ __forceinline__ void xcd_barrier_complete(unsigned* bar, unsigned x, unsigned& nloc, unsigned& nx) {
    const unsigned G = gridDim.x * gridDim.y * gridDim.z;
    unsigned sum, cnt, mine, sp = 0u;
    for (;;) {
        sum = 0u; cnt = 0u; mine = 0u;
#pragma unroll
        for (unsigned j = 0; j < 16; ++j) { const unsigned c = xb_ld(&bar[XB_XCNT(j)]); sum += c; cnt += (c > 0u) ? 1u : 0u; mine = (j == x) ? c : mine; }
        if (sum == G) break;
        __builtin_amdgcn_s_sleep(1);
        if ((++sp & 255u) == 0u) { if (xb_ld(&bar[XB_TMO])) break; if (sp > XB_SPIN_CAP) { atomicAdd(&bar[XB_TMO], 1u); break; } }
    }
    nloc = mine > 0u ? mine : 1u; nx = cnt > 0u ? cnt : 1u;
}
__device__ __forceinline__ void xcd_barrier(const XcdBarrier& b) {
    asm volatile("s_waitcnt vmcnt(0)" ::: "memory");
    __syncthreads();
    if (b.wave == 0 && lane_id() == 0) {
        unsigned* bar = b.bar;
        __builtin_amdgcn_s_waitcnt(0);
        unsigned nloc = b.st[0], nx = b.st[1];
        if (nloc == 0u) { xcd_barrier_complete(bar, b.x, nloc, nx); b.st[0] = nloc; b.st[1] = nx; }
        const unsigned old = xb_add(&bar[XB_XSUB(b.x)], 1u);
        const unsigned gen = old / nloc;
        if (old + 1u == (gen + 1u) * nloc) {
            __builtin_amdgcn_fence(__ATOMIC_RELEASE, "agent");
            asm volatile("s_waitcnt vmcnt(0)" ::: "memory");
            const unsigned og = xb_add(&bar[XB_TOP], 1u);
            const unsigned tg = og / nx;
            if (og + 1u == (tg + 1u) * nx) xb_add(&bar[XB_TOPGEN], 1u);
            else XB_SPIN(xb_ld(&bar[XB_TOPGEN]) == tg, bar);
            __builtin_amdgcn_fence(__ATOMIC_ACQUIRE, "agent");
            xb_add(&bar[XB_XGEN(b.x)], 1u);
            asm volatile("s_waitcnt vmcnt(0)" ::: "memory");
        } else {
            XB_SPIN(xb_ld(&bar[XB_XGEN(b.x)]) == gen, bar);
            __builtin_amdgcn_fence(__ATOMIC_ACQUIRE, "agent");
            asm volatile("s_waitcnt vmcnt(0)" ::: "memory");
        }
    }
    __syncthreads();
}

namespace pg8 {
constexpr int BM = 256, BK = 64, HALF = 128, HTB = HALF * BK * 2, STAGE_BYTES = 8 * HTB, NXCD = 8, WGM = 4, WGM_NARROW = 4;

__host__ __device__ __forceinline__ int lds_byte(int r, int c) { const int st = (r >> 4) * 2 + (c >> 5), rr = r & 15, cc = c & 31, ob = rr * 64 + cc * 2; return st * 1024 + (ob ^ (((ob >> 9) & 1) << 5)); }
__host__ __device__ __forceinline__ void stage_rc(int b, int& R, int& C) { const int st = b / 1024, sb = b % 1024, swz = sb ^ (((sb >> 9) & 1) << 5); R = (st >> 1) * 16 + swz / 64; C = (st & 1) * 32 + (swz % 64) / 2; }
__host__ __device__ __forceinline__ int perm32(int rho) { const int n = rho >> 4, i = rho & 15; return 8 * (i >> 2) + 4 * n + (i & 3); }

struct Unit { int pm, pn, seq; };
struct Gemm { const bf16_t* A; const bf16_t* Bt; int lda, ldb, K; };

struct BMapPlain { static __device__ __forceinline__ long off(int h, int R, int ldb) { return (long)(h * HALF + R) * ldb; } };
struct BMapPerm  { static __device__ __forceinline__ long off(int h, int R, int ldb) { return (long)(h * HALF + (R & ~31) + perm32(R & 31)) * ldb; } };

struct StaticOrder {
    int nM, nN, nwg, G, c;
    __host__ __device__ void init(int M, int N, int G_, int c_) { nM = M / BM; nN = N / BM; nwg = nM * nN; G = G_; c = c_; }
    __host__ __device__ bool next(int i, Unit& u) const {
        const long L = (long)i * G + c; if (L >= nwg) return false;
        int wgid = (int)L; { const int q = nwg / NXCD, r = nwg % NXCD, xcd = wgid % NXCD, off = wgid / NXCD; wgid = (xcd < r ? xcd * (q + 1) : r * (q + 1) + (xcd - r) * q) + off; }
        const int wgm = nN <= 8 ? WGM_NARROW : WGM;
        const int nig = wgm * nN, gid = wgid / nig, fm = gid * wgm, gsz = (nM - fm) < wgm ? (nM - fm) : wgm;
        u.pm = fm + ((wgid % nig) % gsz); u.pn = (wgid % nig) / gsz; u.seq = i;
        u.pn = (u.pn + gid * nN / NXCD) % nN;
        return true;
    }
    __device__ __forceinline__ long a_off(const Unit& u, int lda) const { return (long)u.pm * BM * lda; }
    __device__ __forceinline__ long b_off(const Unit& u, int ldb) const { return (long)u.pn * BM * ldb; }
};

struct UpperHalfOrder {
    int nN, nwg, G, c;
    __host__ __device__ void init(int M, int N, int G_, int c_) { nN = N / BM; nwg = (M / BM) * nN; G = G_; c = c_; }
    __host__ __device__ bool next(int i, Unit& u) const { const int lo = G / 2; if (c < lo) return false; const int L = (c - lo) + i * (G - lo); if (L >= nwg) return false; u.pm = L / nN; u.pn = L % nN; u.seq = i; return true; }
    __device__ __forceinline__ long a_off(const Unit& u, int lda) const { return (long)u.pm * BM * lda; }
    __device__ __forceinline__ long b_off(const Unit& u, int ldb) const { return (long)u.pn * BM * ldb; }
};

template <class E> __device__ __forceinline__ auto call_pre(const E& e, const Unit& u, int wave, int lane, int) -> decltype(e.pre(u, wave, lane), void()) { e.pre(u, wave, lane); }
template <class E> __device__ __forceinline__ void call_pre(const E&, const Unit&, int, int, long) {}
template <class Epi, class Sched, class BMap>
__device__ __forceinline__ void gemm_phase(LAS unsigned char* lds, int wave, const Gemm g, const Sched& S, const Epi& E) {
    int tid_ = wave * 64 + lane_id(); asm volatile("" : "+v"(tid_));
    const int tid = tid_, wid = wave, lane = tid & 63, wr = wid >> 2, wc = wid & 3, fr = lane & 15, fq = lane >> 4;
    const int K = g.K, nt = K / BK;
    unsigned voffA[2], voffB0[2], voffB1[2];
#pragma unroll
    for (int i = 0; i < 2; ++i) { int R, C; stage_rc(tid * 16 + i * 8192, R, C);
        voffA[i] = (unsigned)(R * g.lda + C) * 2u;
        voffB0[i] = (unsigned)(BMap::off(0, R, g.ldb) + C) * 2u; voffB1[i] = (unsigned)(BMap::off(1, R, g.ldb) + C) * 2u; }
    const size_t kstep = (size_t)(BK * 2);
    const size_t hstepA = (size_t)HALF * g.lda * 2;
    const unsigned ldsw = (unsigned)wid * 1024u;
    const int aoff = lds_byte(wr * 64 + fr, fq * 8), boff = lds_byte(wc * 32 + fr, fq * 8);
#define PG8_SA(b, h) (((b) * 2 + (h)) * HTB)
#define PG8_SB(b, h) ((4 + (b) * 2 + (h)) * HTB)
#define PG8_STAGE(bufoff, gbase, voff) do { _Pragma("unroll") for (int _i = 0; _i < 2; ++_i) \
        __builtin_amdgcn_global_load_lds((const unsigned*)((const char*)(gbase) + (voff)[_i]), (LAS unsigned*)(lds + (bufoff) + ldsw + _i * 8192), 16, 0, 0); } while (0)
#define PG8_LDA(dst, b, h) do { _Pragma("unroll") for (int m = 0; m < 4; ++m) _Pragma("unroll") for (int k = 0; k < 2; ++k) dst[m][k] = *(const LAS bf16x8*)(lds + PG8_SA(b, h) + aoff + m * 2048 + k * 1024); } while (0)
#define PG8_LDB(dst, b, h) do { _Pragma("unroll") for (int n = 0; n < 2; ++n) _Pragma("unroll") for (int k = 0; k < 2; ++k) dst[n][k] = *(const LAS bf16x8*)(lds + PG8_SB(b, h) + boff + n * 2048 + k * 1024); } while (0)
#define PG8_MMA(ai, bj, At, Bt) do { __builtin_amdgcn_s_setprio(1); _Pragma("unroll") for (int m = 0; m < 4; ++m) _Pragma("unroll") for (int n = 0; n < 2; ++n) _Pragma("unroll") for (int k = 0; k < 2; ++k) \
        acc[ai][bj][m][n] = __builtin_amdgcn_mfma_f32_16x16x32_bf16(Bt[n][k], At[m][k], acc[ai][bj][m][n], 0, 0, 0); __builtin_amdgcn_s_setprio(0); } while (0)
#define PG8_WAIT_V(n) asm volatile("s_waitcnt vmcnt(" #n ")" ::: "memory")
#define PG8_WAIT_L(n) asm volatile("s_waitcnt lgkmcnt(" #n ")" ::: "memory")
#define PG8_BAR __builtin_amdgcn_s_barrier()
#define PG8_SCHED __builtin_amdgcn_sched_barrier(0)
    Unit cur, nxt; int ui = 0;
    if (!S.next(0, cur)) return;
    f32x4 acc[2][2][4][2];
#pragma unroll
    for (int a = 0; a < 2; ++a)
#pragma unroll
        for (int b = 0; b < 2; ++b)
#pragma unroll
            for (int m = 0; m < 4; ++m)
#pragma unroll
                for (int n = 0; n < 2; ++n) acc[a][b][m][n] = (f32x4){0.f, 0.f, 0.f, 0.f};
    bf16x8 At[4][2], B0[2][2], B1[2][2];
    const char* cA = (const char*)(g.A + S.a_off(cur, g.lda)); const char* cB = (const char*)(g.Bt + S.b_off(cur, g.ldb));
    call_pre(E, cur, wid, lane, 0);
    PG8_STAGE(PG8_SB(0, 0), cB, voffB0); PG8_STAGE(PG8_SB(0, 1), cB, voffB1); PG8_STAGE(PG8_SA(0, 0), cA, voffA); PG8_STAGE(PG8_SA(0, 1), cA + hstepA, voffA);
    if (wr == 1) PG8_BAR;
    PG8_WAIT_V(2); PG8_BAR;
    PG8_STAGE(PG8_SB(1, 0), cB + kstep, voffB0); PG8_STAGE(PG8_SA(1, 0), cA + kstep, voffA); PG8_STAGE(PG8_SB(1, 1), cB + kstep, voffB1);
    PG8_WAIT_V(6); PG8_BAR;
#pragma unroll 1
    for (;;) {
        const bool has_next = S.next(ui + 1, nxt);
        const char* nA = has_next ? (const char*)(g.A + S.a_off(nxt, g.lda)) : cA; const char* nB = has_next ? (const char*)(g.Bt + S.b_off(nxt, g.ldb)) : cB;
#pragma unroll 1
        for (int t = 0; t < nt; t += 2) {
            const bool last = (t == nt - 2);
            const char* a1 = cA + (size_t)(t + 1) * kstep;
            const char* a2 = last ? nA : cA + (size_t)(t + 2) * kstep; const char* b2 = last ? nB : cB + (size_t)(t + 2) * kstep;
            const char* a3 = a2 + kstep; const char* b3 = b2 + kstep;
            PG8_LDB(B0, 0, 0); PG8_LDB(B1, 0, 1); PG8_SCHED; PG8_LDA(At, 0, 0); PG8_STAGE(PG8_SA(1, 1), a1 + hstepA, voffA);
            PG8_WAIT_V(8); PG8_WAIT_L(0); PG8_BAR; PG8_MMA(0, 0, At, B0); PG8_MMA(0, 1, At, B1); PG8_BAR; PG8_SCHED;
            PG8_LDA(At, 0, 1); PG8_STAGE(PG8_SB(0, 0), b2, voffB0); PG8_STAGE(PG8_SB(0, 1), b2, voffB1); PG8_STAGE(PG8_SA(0, 0), a2, voffA);
            PG8_WAIT_V(8); PG8_WAIT_L(0); PG8_BAR; PG8_MMA(1, 0, At, B0); PG8_MMA(1, 1, At, B1); PG8_BAR; PG8_SCHED;
            PG8_LDB(B0, 1, 0); PG8_LDB(B1, 1, 1); PG8_SCHED; PG8_LDA(At, 1, 0); PG8_STAGE(PG8_SA(0, 1), a2 + hstepA, voffA);
            PG8_WAIT_V(8); PG8_WAIT_L(0); PG8_BAR; PG8_MMA(0, 0, At, B0); PG8_MMA(0, 1, At, B1); PG8_BAR; PG8_SCHED;
            PG8_LDA(At, 1, 1); PG8_STAGE(PG8_SB(1, 0), b3, voffB0); PG8_STAGE(PG8_SB(1, 1), b3, voffB1); PG8_STAGE(PG8_SA(1, 0), a3, voffA);
            PG8_WAIT_V(8); PG8_WAIT_L(0); PG8_BAR; PG8_MMA(1, 0, At, B0); PG8_MMA(1, 1, At, B1); PG8_BAR; PG8_SCHED;
        }
        if (wr == 0) PG8_BAR;
        E(acc, cur, wr, wc, fr, fq);
        if (!has_next) break;
        call_pre(E, nxt, wid, lane, 0);
#pragma unroll
        for (int a = 0; a < 2; ++a)
#pragma unroll
            for (int b = 0; b < 2; ++b)
#pragma unroll
                for (int m = 0; m < 4; ++m)
#pragma unroll
                    for (int n = 0; n < 2; ++n) acc[a][b][m][n] = (f32x4){0.f, 0.f, 0.f, 0.f};
        cur = nxt; cA = nA; cB = nB; ++ui;
        if (wr == 1) PG8_BAR;
    }
    PG8_WAIT_V(0);
    PG8_BAR;
#undef PG8_SA
#undef PG8_SB
#undef PG8_STAGE
#undef PG8_LDA
#undef PG8_LDB
#undef PG8_MMA
#undef PG8_WAIT_V
#undef PG8_WAIT_L
#undef PG8_BAR
#undef PG8_SCHED
}

struct EpiBf16 {
    bf16_t* O; int ldc;
    __device__ __forceinline__ void operator()(const f32x4 (&acc)[2][2][4][2], const Unit& u, int wr, int wc, int fr_, int fq) const {
        int fr = fr_; asm volatile("" : "+v"(fr));
        const int row0 = u.pm * BM + wr * 64 + fr, col0 = u.pn * BM + wc * 32 + 8 * fq;
#pragma unroll
        for (int ai = 0; ai < 2; ++ai)
#pragma unroll
            for (int m = 0; m < 4; ++m) { bf16_t* rowp = O + (size_t)(row0 + ai * HALF + m * 16) * ldc + col0;
#pragma unroll
                for (int bj = 0; bj < 2; ++bj) { const f32x4 v0 = acc[ai][bj][m][0], v1 = acc[ai][bj][m][1];
                    u32x4 w; w.x = cvt_pk_bf16(v0[0], v0[1]); w.y = cvt_pk_bf16(v0[2], v0[3]); w.z = cvt_pk_bf16(v1[0], v1[1]); w.w = cvt_pk_bf16(v1[2], v1[3]);
                    *(u32x4*)(rowp + bj * HALF) = w; } }
    }
};
template <class Sel> struct EpiRope {
    bf16_t* O; int ldc; const f32x2* cs; unsigned char* kv8;
    __device__ __forceinline__ void operator()(const f32x4 (&acc)[2][2][4][2], const Unit& u, int wr, int wc, int fr_, int fq) const {
        int fr = fr_; asm volatile("" : "+v"(fr));
        const int row0 = u.pm * BM + wr * 64 + fr, col0 = u.pn * BM + wc * 32 + 8 * fq;
        const bool any = Sel::tile_any(u.pn);
#pragma unroll
        for (int ai = 0; ai < 2; ++ai)
#pragma unroll
            for (int m = 0; m < 4; ++m) { const int row = row0 + ai * HALF + m * 16; bf16_t* rowp = O + (size_t)row * ldc + col0;
#pragma unroll
                for (int bj = 0; bj < 2; ++bj) { f32x4 v0 = acc[ai][bj][m][0], v1 = acc[ai][bj][m][1];
                    if (any) { const int j0 = Sel::j0(col0 + bj * HALF);
                        if (j0 >= 0) { const f32x4 c01 = *(const f32x4*)(cs + (size_t)row * 32 + j0), c23 = *(const f32x4*)(cs + (size_t)row * 32 + j0 + 2);
                            f32x4 r0, r1;
                            r0[0] = v0[0] * c01[0] - v0[1] * c01[1]; r0[1] = v0[0] * c01[1] + v0[1] * c01[0];
                            r0[2] = v0[2] * c01[2] - v0[3] * c01[3]; r0[3] = v0[2] * c01[3] + v0[3] * c01[2];
                            r1[0] = v1[0] * c23[0] - v1[1] * c23[1]; r1[1] = v1[0] * c23[1] + v1[1] * c23[0];
                            r1[2] = v1[2] * c23[2] - v1[3] * c23[3]; r1[3] = v1[2] * c23[3] + v1[3] * c23[2];
                            v0 = r0; v1 = r1; } }
                    u32x4 w; w.x = cvt_pk_bf16(v0[0], v0[1]); w.y = cvt_pk_bf16(v0[2], v0[3]); w.z = cvt_pk_bf16(v1[0], v1[1]); w.w = cvt_pk_bf16(v1[2], v1[3]);
                    *(u32x4*)(rowp + bj * HALF) = w;
                    if (kv8 && (u.pn >> 2) == 2) { int a = __builtin_amdgcn_cvt_pk_fp8_f32(v0[0], v0[1], 0, false); a = __builtin_amdgcn_cvt_pk_fp8_f32(v0[2], v0[3], a, true);
                        int b = __builtin_amdgcn_cvt_pk_fp8_f32(v1[0], v1[1], 0, false); b = __builtin_amdgcn_cvt_pk_fp8_f32(v1[2], v1[3], b, true);
                        const int cc = col0 + bj * HALF - 2048;
                        *(u32x2*)(kv8 + (size_t)(cc >> 7) * (SEQ * 128) + (size_t)row * 128 + (cc & 127)) = (u32x2){(unsigned)a, (unsigned)b}; } } }
    }
};
struct EpiUkv {
    bf16_t* Kb; bf16_t* Vb;
    __device__ __forceinline__ void operator()(const f32x4 (&acc)[2][2][4][2], const Unit& u, int wr, int wc, int fr_, int fq) const {
        int fr = fr_; asm volatile("" : "+v"(fr));
        const int row0 = u.pm * BM + wr * 64 + fr, c0 = wc * 32 + 8 * fq;
#pragma unroll
        for (int ai = 0; ai < 2; ++ai)
#pragma unroll
            for (int m = 0; m < 4; ++m) { const size_t row = (size_t)(row0 + ai * HALF + m * 16);
#pragma unroll
                for (int bj = 0; bj < 2; ++bj) { const f32x4 v0 = acc[ai][bj][m][0], v1 = acc[ai][bj][m][1];
                    u32x4 w; w.x = cvt_pk_bf16(v0[0], v0[1]); w.y = cvt_pk_bf16(v0[2], v0[3]); w.z = cvt_pk_bf16(v1[0], v1[1]); w.w = cvt_pk_bf16(v1[2], v1[3]);
                    bf16_t* p = bj == 0 ? Kb + row * 3072 + u.pn * 192 + c0 : Vb + row * 2048 + u.pn * 128 + c0;
                    *(u32x4*)p = w; } }
    }
};
struct EpiResid {
    const float* base; float* out; int ldc;
    __device__ __forceinline__ void operator()(const f32x4 (&acc)[2][2][4][2], const Unit& u, int wr, int wc, int fr_, int fq) const {
        int fr = fr_; asm volatile("" : "+v"(fr));
        const int row0 = u.pm * BM + wr * 64 + fr, col0 = u.pn * BM + wc * 32 + 4 * fq;
#pragma unroll
        for (int ai = 0; ai < 2; ++ai)
#pragma unroll
            for (int m = 0; m < 4; ++m) { const size_t off = (size_t)(row0 + ai * HALF + m * 16) * ldc + col0;
#pragma unroll
                for (int bj = 0; bj < 2; ++bj)
#pragma unroll
                    for (int n = 0; n < 2; ++n) { const f32x4 b = *(const f32x4*)(base + off + bj * HALF + n * 16); *(f32x4*)(out + off + bj * HALF + n * 16) = b + acc[ai][bj][m][n]; }
                if (m & 1) asm volatile("" ::: "memory"); }
    }
};
struct EpiNull { float* sink;
    __device__ __forceinline__ void operator()(const f32x4 (&acc)[2][2][4][2], const Unit& u, int wr, int wc, int fr, int fq) const {
        float t = 0.f;
#pragma unroll
        for (int ai = 0; ai < 2; ++ai)
#pragma unroll
            for (int bj = 0; bj < 2; ++bj)
#pragma unroll
                for (int m = 0; m < 4; ++m)
#pragma unroll
                    for (int n = 0; n < 2; ++n) t += acc[ai][bj][m][n][0];
        if (t == 123.456f) sink[0] = t; } };
struct EpiSwiGLU {
    bf16_t* O; int ldc;
    static __device__ __forceinline__ float silu_mul(float g, float u) { return g * u * __builtin_amdgcn_rcpf(1.0f + __builtin_amdgcn_exp2f(-g * LOG2E)); }
    __device__ __forceinline__ void operator()(const f32x4 (&acc)[2][2][4][2], const Unit& u, int wr, int wc, int fr_, int fq) const {
        int fr = fr_; asm volatile("" : "+v"(fr));
        const int row0 = u.pm * BM + wr * 64 + fr, col0 = u.pn * HALF + wc * 32 + 8 * fq;
#pragma unroll
        for (int ai = 0; ai < 2; ++ai)
#pragma unroll
            for (int m = 0; m < 4; ++m) { bf16_t* rowp = O + (size_t)(row0 + ai * HALF + m * 16) * ldc + col0;
                const f32x4 g0 = acc[ai][0][m][0], g1 = acc[ai][0][m][1], u0 = acc[ai][1][m][0], u1 = acc[ai][1][m][1];
                u32x4 w; w.x = cvt_pk_bf16(silu_mul(g0[0], u0[0]), silu_mul(g0[1], u0[1])); w.y = cvt_pk_bf16(silu_mul(g0[2], u0[2]), silu_mul(g0[3], u0[3]));
                w.z = cvt_pk_bf16(silu_mul(g1[0], u1[0]), silu_mul(g1[1], u1[1])); w.w = cvt_pk_bf16(silu_mul(g1[2], u1[2]), silu_mul(g1[3], u1[3]));
                *(u32x4*)rowp = w; }
    }
};
struct EpiPLE {
    float* h; const bf16_t* proj; int ldc;
    __device__ __forceinline__ void operator()(const f32x4 (&acc)[2][2][4][2], const Unit& u, int wr, int wc, int fr_, int fq) const {
        int fr = fr_; asm volatile("" : "+v"(fr));
        const int row0 = u.pm * BM + wr * 64 + fr, col0 = u.pn * BM + wc * 32 + 4 * fq;
#pragma unroll
        for (int ai = 0; ai < 2; ++ai)
#pragma unroll
            for (int m = 0; m < 4; ++m) { const size_t off = (size_t)(row0 + ai * HALF + m * 16) * ldc + col0;
#pragma unroll
                for (int bj = 0; bj < 2; ++bj)
#pragma unroll
                    for (int n = 0; n < 2; ++n) { const size_t o = off + bj * HALF + n * 16; const f32x4 b = *(const f32x4*)(h + o); const u32x2 pw = *(const u32x2*)(proj + o);
                        const f32x4 a = acc[ai][bj][m][n]; f32x4 r;
                        r[0] = b[0] + bf_lo(pw.x) * __builtin_amdgcn_rcpf(1.0f + __builtin_amdgcn_exp2f(-a[0] * LOG2E));
                        r[1] = b[1] + bf_hi(pw.x) * __builtin_amdgcn_rcpf(1.0f + __builtin_amdgcn_exp2f(-a[1] * LOG2E));
                        r[2] = b[2] + bf_lo(pw.y) * __builtin_amdgcn_rcpf(1.0f + __builtin_amdgcn_exp2f(-a[2] * LOG2E));
                        r[3] = b[3] + bf_hi(pw.y) * __builtin_amdgcn_rcpf(1.0f + __builtin_amdgcn_exp2f(-a[3] * LOG2E));
                        *(f32x4*)(h + o) = r; }
                if (m & 1) asm volatile("" ::: "memory"); }
    }
};
}
struct Params {
    const float* x; const float* p; const int* pos; const float* t5;
    const float* a_w_in; const float* a_w_out; const float* b_w_in; const float* b_rel; const float* b_w_out;
    const float* c_w_down; const float* c_qn; const float* c_kvn; const float* c_w_uq; const float* c_w_ukv; const float* c_w_out;
    const float* attn_norm; const float* ffn_norm; const float* ffn_w_in; const float* ffn_w_out; const float* ple_norm; const float* ple_w_gate; const float* ple_w_proj;
    const float* final_norm;
    float* out; unsigned char* ws;
};
struct ParamsG {
    const float GAS* x; const float GAS* p; const int GAS* pos; const float GAS* t5;
    const float GAS* a_w_in; const float GAS* a_w_out; const float GAS* b_w_in; const float GAS* b_rel; const float GAS* b_w_out;
    const float GAS* c_w_down; const float GAS* c_qn; const float GAS* c_kvn; const float GAS* c_w_uq; const float GAS* c_w_ukv; const float GAS* c_w_out;
    const float GAS* attn_norm; const float GAS* ffn_norm; const float GAS* ffn_w_in; const float GAS* ffn_w_out; const float GAS* ple_norm; const float GAS* ple_w_gate; const float GAS* ple_w_proj;
    const float GAS* final_norm;
    float GAS* out; unsigned char GAS* ws;
};
static_assert(sizeof(ParamsG) == sizeof(Params), "device view of the kernel argument");
typedef const ParamsG __attribute__((address_space(4))) KParams;
typedef KParams& KP;
__device__ __forceinline__ KParams* kparams() { KParams* kp = (KParams*)__builtin_amdgcn_kernarg_segment_ptr(); asm volatile("" : "+s"(kp)); return kp; }
template <class T> __device__ __forceinline__ T* G(T GAS* p) { return (T*)p; }
struct Frame {
    LAS unsigned char* lds;
    int wave;
    int G, bid;
    int gw, NGW;
};

struct CMapId { int nsrc; __device__ __forceinline__ int operator()(int n) const { return n < nsrc ? n : -1; } };
struct CMapAin {
    __device__ __forceinline__ int operator()(int n) const {
        if (n < AQI_OFF) return n;
        if (n < AWI_OFF) { const int r = n - AQI_OFF, hd = r >> 7, dp = r & 127; const int d = dp < 64 ? ((dp >> 1) + 32 * (dp & 1)) : dp; return AQI_OFF + hd * 128 + d; }
        return n < A_IN ? n : -1; }
};
struct CMapFfn {
    __device__ __forceinline__ int operator()(int n) const { const int t = n >> 8, s = (n >> 7) & 1, j = n & 127; return s * FFH + 128 * t + j; }
};
struct CMapUq {
    __device__ __forceinline__ int operator()(int n) const { const int h = n / 192, dp = n - h * 192; if (dp < 128) return n; const int r = dp - 128; return h * 192 + 128 + (r >> 1) + 32 * (r & 1); }
};
template <class CM>
__device__ __forceinline__ void convert_matrix(const Frame& F, const float* W, int K, int Nsrc, bf16_t* WT, int Npad, const CM cm, const float* gain, int& rot) {
    LAS float* scr = (LAS float*)(F.lds + F.wave * 16384);
    const int nblk = Npad / 32, nitems = (K / 64) * nblk, lane = lane_id();
    int start = F.gw - rot; if (start < 0) start += F.NGW;
    rot = (rot + nitems) % F.NGW;
    const int n4 = lane & 7, kr = lane >> 3;
    for (int item = start; item < nitems; item += F.NGW) {
        const int kb = item / nblk, nb = item - kb * nblk, k0 = 64 * kb, n0 = 32 * nb;
        const int s0 = cm(n0 + 4 * n4), s1 = cm(n0 + 4 * n4 + 1), s2 = cm(n0 + 4 * n4 + 2), s3 = cm(n0 + 4 * n4 + 3);
        const bool vec = s0 >= 0 && s1 == s0 + 1 && s2 == s0 + 2 && s3 == s0 + 3 && (s0 & 3) == 0;
        const float* src = W + (size_t)(k0 + kr) * Nsrc;
        f32x4 v[8];
        if (vec) {
#pragma unroll
            for (int i = 0; i < 8; ++i) v[i] = *(const f32x4*)(src + (size_t)(8 * i) * Nsrc + s0);
        } else {
#pragma unroll
            for (int i = 0; i < 8; ++i) { const float* r = src + (size_t)(8 * i) * Nsrc;
                v[i].x = s0 >= 0 ? r[s0] : 0.f; v[i].y = s1 >= 0 ? r[s1] : 0.f; v[i].z = s2 >= 0 ? r[s2] : 0.f; v[i].w = s3 >= 0 ? r[s3] : 0.f; }
        }
#pragma unroll
        for (int i = 0; i < 8; ++i) { const int kk = kr + 8 * i; f32x4 x = v[i]; if (gain) x = x * gain[k0 + kk];
            LAS float* d = scr + kk * 33 + 4 * n4; d[0] = x.x; d[1] = x.y; d[2] = x.z; d[3] = x.w; }
        LDS_WAIT(); asm volatile("" ::: "memory");
        const int c = lane & 7;
#pragma unroll
        for (int j = 0; j < 4; ++j) { const int n = (lane >> 3) + 8 * j; const LAS float* s = scr + (8 * c) * 33 + n;
            u32x4 o; o.x = pk2(s[0 * 33], s[1 * 33]); o.y = pk2(s[2 * 33], s[3 * 33]); o.z = pk2(s[4 * 33], s[5 * 33]); o.w = pk2(s[6 * 33], s[7 * 33]);
            *(GAS u32x4*)(WT + (size_t)(n0 + n) * K + k0 + 8 * c) = o; }
        LDS_WAIT(); asm volatile("" ::: "memory");
    }
}
template <bool OUT_F32>
__device__ __forceinline__ void norm_rows(const Frame& F, const float* src, const float* gain, void* dst) {
    const int lane = lane_id();
    for (int m = F.gw; m < SEQ; m += F.NGW) {
        const GAS f32x4* xr = (const GAS f32x4*)(src + (size_t)m * DM) + lane;
        f32x4 v[8]; float s = 0.f;
#pragma unroll
        for (int j = 0; j < 8; ++j) { v[j] = xr[64 * j]; s += (v[j].x * v[j].x + v[j].y * v[j].y) + (v[j].z * v[j].z + v[j].w * v[j].w); }
        const float rs = 1.0f / sqrtf(wave_sum(s) * (1.f / DM) + EPS);
#pragma unroll
        for (int j = 0; j < 8; ++j) { const f32x4 g = *((const GAS f32x4*)gain + lane + 64 * j); const f32x4 o = v[j] * rs * g;
            if (OUT_F32) *((GAS f32x4*)((float*)dst + (size_t)m * DM) + lane + 64 * j) = o;
            else { u32x2 w; w.x = pk2(o.x, o.y); w.y = pk2(o.z, o.w); *((GAS u32x2*)((bf16_t*)dst + (size_t)m * DM) + lane + 64 * j) = w; } }
    }
}
__device__ __forceinline__ void p0_prologue(const Frame& F, KP P) {
    unsigned char* ws = G(P.ws);
    { f32x2* cs = (f32x2*)(ws + WS_CS); const int gt = F.bid * NTHREADS + F.wave * 64 + lane_id(), NT = F.G * NTHREADS;
      for (int i = gt; i < SEQ * 32; i += NT) { const int row = i >> 5, j = i & 31;
          const double inv = exp(-(double)j * (9.210340371976184 / 32.0)); double t = (double)G(P.pos)[row] * inv * 0.15915494309189535; t -= floor(t);
          const float tf = (float)t; cs[i] = (f32x2){__builtin_amdgcn_cosf(tf), __builtin_amdgcn_sinf(tf)}; }
      const f32x4* p4 = (const f32x4*)G(P.p); u32x2* pb = (u32x2*)(ws + WS_PB);
      for (int i = gt; i < DEPTH * SEQ * PLE / 4; i += NT) { const f32x4 v = p4[i]; u32x2 w; w.x = pk2(v.x, v.y); w.y = pk2(v.z, v.w); pb[i] = w; } }
    int rot = 0;
    for (int j = 0; j < 2; ++j) {
        convert_matrix(F, G(P.a_w_in) + (size_t)j * DM * A_IN, DM, A_IN, (bf16_t*)(ws + (j ? WA1 : WA0)), A_INP, CMapAin{}, nullptr, rot);
        convert_matrix(F, G(P.a_w_out) + (size_t)j * DM * DM, DM, DM, (bf16_t*)(ws + (j ? WA1 : WA0) + W_AIN), DM, CMapId{DM}, nullptr, rot);
    }
    convert_matrix(F, G(P.b_w_in), DM, B_IN, (bf16_t*)(ws + WB_IN), B_IN, CMapId{B_IN}, nullptr, rot);
    convert_matrix(F, G(P.b_w_out), DM, DM, (bf16_t*)(ws + WB_OUT), DM, CMapId{DM}, nullptr, rot);
    convert_matrix(F, G(P.c_w_down), DM, C_DOWN, (bf16_t*)(ws + WC_DOWN), C_DOWNP, CMapId{C_DOWN}, nullptr, rot);
    convert_matrix(F, G(P.c_w_uq), 512, C_UQ, (bf16_t*)(ws + WC_UQ), C_UQ, CMapUq{}, nullptr, rot);
    convert_matrix(F, G(P.c_w_ukv), 512, C_UKV, (bf16_t*)(ws + WC_UKV), C_UKV, CMapId{C_UKV}, nullptr, rot);
    convert_matrix(F, G(P.c_w_out), DM, DM, (bf16_t*)(ws + WC_OUT), DM, CMapId{DM}, nullptr, rot);
    for (int i = 0; i < DEPTH; ++i) {
        unsigned char* wl = ws + WL0 + (size_t)i * WL_SIZE;
        convert_matrix(F, G(P.ffn_w_in) + (size_t)i * DM * 2 * FFH, DM, 2 * FFH, (bf16_t*)(wl + WL_FIN), 2 * FFH, CMapFfn{}, nullptr, rot);
        convert_matrix(F, G(P.ffn_w_out) + (size_t)i * FFH * DM, FFH, DM, (bf16_t*)(wl + WL_FOUT), DM, CMapId{DM}, nullptr, rot);
        convert_matrix(F, G(P.ple_w_gate) + (size_t)i * DM * DM, DM, DM, (bf16_t*)(wl + WL_GATE), DM, CMapId{DM}, nullptr, rot);
        convert_matrix(F, G(P.ple_w_proj) + (size_t)i * PLE * DM, PLE, DM, (bf16_t*)(wl + WL_PROJ), DM, CMapId{DM}, nullptr, rot);
    }
}
#ifndef REP_BAND
#define REP_BAND 1
#endif
#ifndef REP_MLA
#define REP_MLA 1
#endif
#ifndef REP_IDX
#define REP_IDX 1
#endif
#ifndef REP_TOPK
#define REP_TOPK 1
#endif
#ifndef REP_SPARSE
#define REP_SPARSE 1
#endif
#ifndef REP_PRO
#define REP_PRO 1
#endif
#ifndef REP_FFNIN
#define REP_FFNIN 1
#endif
#ifndef REP_NORM
#define REP_NORM 1
#endif
#define GRID_BAR() xcd_barrier(bar)

template <class Epi, class BMap>
__device__ __forceinline__ void run_gemm(const Frame& F, const bf16_t* A, int lda, const bf16_t* Bt, int ldb, int K, int N, const Epi& E) {
    pg8::Gemm g{A, Bt, lda, ldb, K}; pg8::StaticOrder S; S.init(SEQ, N, F.G, F.bid);
    pg8::gemm_phase<Epi, pg8::StaticOrder, BMap>(F.lds, F.wave, g, S, E);
}

namespace fa {
typedef short v4i16_t __attribute__((ext_vector_type(4)));
constexpr int LDS_K = 0, KBUF = 24576, LDS_V = 49152, VBUF = 16384, LDS_WS = 81920, LDS_POS = 83968, LDS_TAB = 84480;
__device__ __forceinline__ int crow(int r, int hi) { return (r & 3) + 8 * (r >> 2) + 4 * hi; }
template <int DQK> __device__ __forceinline__ int kswz(int row, int colB) { return row * (DQK * 2) + (colB ^ ((row & 7) << 4)); }
template <int DV> __device__ __forceinline__ int v_st(int k, int c) { const int kk = (k & ~0xC) | ((k & 4) << 1) | ((k & 8) >> 1); return ((kk >> 3) * (DV / 32) + (c >> 5)) * 512 + ((kk & 7) * 32 + (c & 31)) * 2; }
__device__ __forceinline__ int v_rd_base(int lane) { return ((lane & 3) << 3) | (((lane >> 2) & 3) << 6) | (((lane >> 4) & 1) << 5) | (((lane >> 5) & 1) << 8); }
template <int DV> constexpr int v_rd_off(int d0, int ks, int half) { return d0 * 512 + ks * (1024 * (DV / 32)) + half * (512 * (DV / 32)); }
__device__ __forceinline__ s16x4 vtr(const LAS char* p) { return __builtin_bit_cast(s16x4, __builtin_amdgcn_ds_read_tr16_b64_v4i16((LAS v4i16_t*)p)); }

template <int DQK, int DV, bool BIAS>
__device__ __forceinline__ void attn_block(LAS char* lds, int wave, const bf16_t* Q, int ldq, const bf16_t* K, int ldk, const bf16_t* V, int ldv, bf16_t* O, int ldo,
                                           int c0, int wch, float c2, const int* pos) {
    const int lane = lane_id(), tid = wave * 64 + lane, r32 = lane & 31, hi = lane >> 5;
    constexpr int ND = DQK / 16, NO = DV / 32;
    LAS float* wsf = (LAS float*)(lds + LDS_WS) + wave * 64;
    const LAS float* tab = (const LAS float*)(lds + LDS_TAB);
    const int cq = c0 + (wave >> 1);
    const int t_lo = (c0 - wch) > 0 ? (c0 - wch) : 0, t_hi = c0 + 3;
    const int a_lo = cq - wch, a_hi = cq;
    bf16x8 qr[ND];
#pragma unroll
    for (int d0 = 0; d0 < ND; ++d0) qr[d0] = *(const bf16x8*)(Q + (size_t)(wave * 32 + r32) * ldq + d0 * 16 + hi * 8);
    int posq = 0; if (BIAS) posq = pos[c0 * 64 + wave * 32 + r32];
    float m_reg = -1e30f, l_reg = 0.f; f32x16 o[NO];
#pragma unroll
    for (int d = 0; d < NO; ++d) o[d] = f32x16{};
    const int vrd = v_rd_base(lane);
    int kro[4];
#pragma unroll
    for (int dd = 0; dd < 4; ++dd) kro[dd] = kswz<DQK>(r32, dd * 32 + hi * 16);
    constexpr int KC = 64 * DQK / 8 / 512, VC = 64 * DV / 8 / 512;
    bf16x8 kreg[KC], vreg[VC]; int preg = 0;
#define FA_FETCH(key0_) do { \
        _Pragma("unroll") for (int i_ = 0; i_ < KC; ++i_) { const int ci = tid + 512 * i_, row = ci / (DQK / 8), c8 = ci % (DQK / 8); kreg[i_] = *(const bf16x8*)(K + (size_t)((key0_) + row) * ldk + c8 * 8); } \
        _Pragma("unroll") for (int i_ = 0; i_ < VC; ++i_) { const int ci = tid + 512 * i_, row = ci / (DV / 8), c8 = ci % (DV / 8); vreg[i_] = *(const bf16x8*)(V + (size_t)((key0_) + row) * ldv + c8 * 8); } \
        if (BIAS) { if (tid < 64) preg = pos[(key0_) + tid]; } } while (0)
#define FA_PUT(buf_) do { \
        _Pragma("unroll") for (int i_ = 0; i_ < KC; ++i_) { const int ci = tid + 512 * i_, row = ci / (DQK / 8), c8 = ci % (DQK / 8); *(LAS bf16x8*)(lds + LDS_K + (buf_) * KBUF + kswz<DQK>(row, c8 * 16)) = kreg[i_]; } \
        _Pragma("unroll") for (int i_ = 0; i_ < VC; ++i_) { const int ci = tid + 512 * i_, row = ci / (DV / 8), c8 = ci % (DV / 8); *(LAS bf16x8*)(lds + LDS_V + (buf_) * VBUF + v_st<DV>(row, c8 * 8)) = vreg[i_]; } \
        if (BIAS) { if (tid < 64) *(LAS int*)(lds + LDS_POS + (buf_) * 256 + tid * 4) = preg; } } while (0)
    __syncthreads();
    FA_FETCH(t_lo * 64); FA_PUT(0);
    __syncthreads();
#pragma unroll 1
    for (int t = t_lo; t <= t_hi; ++t) {
        const int cur = (t - t_lo) & 1;
        if (t < t_hi) FA_FETCH((t + 1) * 64);
        if (t >= a_lo && t <= a_hi) {
            const LAS char* kbuf = lds + LDS_K + cur * KBUF; const LAS char* vb = lds + LDS_V + cur * VBUF + vrd;
            const LAS int* posl = (const LAS int*)(lds + LDS_POS + cur * 256);
            f32x16 p0 = f32x16{}, p1 = f32x16{};
            __builtin_amdgcn_s_setprio(1);
#pragma unroll
            for (int d0 = 0; d0 < ND; ++d0) { const LAS char* a = kbuf + kro[d0 & 3] + (d0 >> 2) * 128;
                const bf16x8 b0 = *(const LAS bf16x8*)a, b1 = *(const LAS bf16x8*)(a + 32 * DQK * 2);
                p0 = __builtin_amdgcn_mfma_f32_32x32x16_bf16(b0, qr[d0], p0, 0, 0, 0);
                p1 = __builtin_amdgcn_mfma_f32_32x32x16_bf16(b1, qr[d0], p1, 0, 0, 0); }
            __builtin_amdgcn_s_setprio(0);
#pragma unroll
            for (int r = 0; r < 16; ++r) {
                if (BIAS) { const int kc = crow(r, hi); int d0i = posq - posl[kc], d1i = posq - posl[kc + 32];
                    d0i = d0i < -128 ? -128 : (d0i > 128 ? 128 : d0i); d1i = d1i < -128 ? -128 : (d1i > 128 ? 128 : d1i);
                    p0[r] = fmaf(p0[r], c2, tab[d0i + 128]); p1[r] = fmaf(p1[r], c2, tab[d1i + 128]); }
                else { p0[r] *= c2; p1[r] *= c2; } }
            float pmax = p0[0];
#pragma unroll
            for (int r = 1; r < 16; ++r) pmax = fmaxf(pmax, p0[r]);
#pragma unroll
            for (int r = 0; r < 16; ++r) pmax = fmaxf(pmax, p1[r]);
            { auto rr = __builtin_amdgcn_permlane32_swap(__float_as_uint(pmax), __float_as_uint(pmax), false, false); pmax = fmaxf(__uint_as_float(rr[0]), __uint_as_float(rr[1])); }
            float alpha = 1.f;
            if (!__all((pmax - m_reg) <= 11.5f)) { const float mn = fmaxf(m_reg, pmax); alpha = __builtin_amdgcn_exp2f(m_reg - mn); m_reg = mn; }
            float ps = 0.f;
#pragma unroll
            for (int r = 0; r < 16; ++r) { p0[r] = __builtin_amdgcn_exp2f(p0[r] - m_reg); p1[r] = __builtin_amdgcn_exp2f(p1[r] - m_reg); ps += p0[r] + p1[r]; }
            { auto rr = __builtin_amdgcn_permlane32_swap(__float_as_uint(ps), __float_as_uint(ps), false, false); ps = __uint_as_float(rr[0]) + __uint_as_float(rr[1]); }
            l_reg = l_reg * alpha + ps;
            bf16x8 pa0, pa1, pa2, pa3;
#define FA_PK4(P, B_, OUT) do { const unsigned a0 = cvt_pk_bf16(P[B_ + 0], P[B_ + 1]), a1 = cvt_pk_bf16(P[B_ + 2], P[B_ + 3]); \
        const unsigned b0_ = cvt_pk_bf16(P[B_ + 4], P[B_ + 5]), b1_ = cvt_pk_bf16(P[B_ + 6], P[B_ + 7]); \
        auto r0 = __builtin_amdgcn_permlane32_swap(a0, b0_, false, false); auto r1 = __builtin_amdgcn_permlane32_swap(a1, b1_, false, false); \
        u32x4 w = {r0[0], r1[0], r0[1], r1[1]}; OUT = __builtin_bit_cast(bf16x8, w); } while (0)
            FA_PK4(p0, 0, pa0); FA_PK4(p0, 8, pa1); FA_PK4(p1, 0, pa2); FA_PK4(p1, 8, pa3);
#undef FA_PK4
            if (__any(alpha < 1.f)) { if (hi == 0) wsf[r32] = alpha; LDS_WAIT();
#pragma unroll
                for (int d = 0; d < NO; ++d)
#pragma unroll
                    for (int r = 0; r < 16; ++r) o[d][r] *= wsf[crow(r, hi)];
                LDS_WAIT(); }
            __builtin_amdgcn_s_setprio(1);
#pragma unroll
            for (int d0 = 0; d0 < NO; ++d0) { s16x4 lo[4], hh[4];
#pragma unroll
                for (int ks = 0; ks < 4; ++ks) { lo[ks] = vtr(vb + v_rd_off<DV>(d0, ks, 0)); hh[ks] = vtr(vb + v_rd_off<DV>(d0, ks, 1)); }
#define FA_VF(k) (bf16x8){lo[k][0], lo[k][1], lo[k][2], lo[k][3], hh[k][0], hh[k][1], hh[k][2], hh[k][3]}
                o[d0] = __builtin_amdgcn_mfma_f32_32x32x16_bf16(pa0, FA_VF(0), o[d0], 0, 0, 0);
                o[d0] = __builtin_amdgcn_mfma_f32_32x32x16_bf16(pa1, FA_VF(1), o[d0], 0, 0, 0);
                o[d0] = __builtin_amdgcn_mfma_f32_32x32x16_bf16(pa2, FA_VF(2), o[d0], 0, 0, 0);
                o[d0] = __builtin_amdgcn_mfma_f32_32x32x16_bf16(pa3, FA_VF(3), o[d0], 0, 0, 0);
#undef FA_VF
            }
            __builtin_amdgcn_s_setprio(0);
        }
        if (t < t_hi) FA_PUT(cur ^ 1);
        __syncthreads();
    }
#undef FA_FETCH
#undef FA_PUT
    if (hi == 0) wsf[32 + r32] = l_reg; LDS_WAIT();
#pragma unroll
    for (int r = 0; r < 16; ++r) { const int orow = crow(r, hi); const float rl = __builtin_amdgcn_rcpf(wsf[32 + orow]);
#pragma unroll
        for (int d0 = 0; d0 < NO; ++d0) { const float v = o[d0][r] * rl; const float vn = __shfl_xor(v, 1);
            if ((r32 & 1) == 0) *(unsigned*)(O + (size_t)(wave * 32 + orow) * ldo + d0 * 32 + r32) = cvt_pk_bf16(v, vn); } }
    LDS_WAIT();
}
}
__device__ __forceinline__ int vcu_of(const Frame& F) { return (F.G % 8 == 0) ? (F.bid % 8) * (F.G / 8) + F.bid / 8 : F.bid; }

__device__ __forceinline__ void mixer_b(const Frame& F, KP P, const XcdBarrier& bar) {
    unsigned char* ws = G(P.ws);
    float* h = (float*)(ws + WS_H); bf16_t* hn = (bf16_t*)(ws + WS_HN);
    bf16_t* qkv = (bf16_t*)(ws + MB_QKV); bf16_t* ob = (bf16_t*)(ws + MB_O);
    norm_rows<false>(F, h, G(P.attn_norm) + 1 * DM, hn);
    GRID_BAR();
    run_gemm<pg8::EpiBf16, pg8::BMapPerm>(F, hn, DM, (const bf16_t*)(ws + WB_IN), DM, DM, B_IN, pg8::EpiBf16{qkv, B_IN});
    GRID_BAR();
    {
        const int vcu = vcu_of(F); LAS char* lds = (LAS char*)F.lds;
        for (int rep_ = 0; rep_ < REP_BAND; ++rep_)
        for (int it = vcu; it < 32 * 32; it += F.G) {
            const int head = it >> 5, qb = it & 31;
            __syncthreads();
            { const int tid = F.wave * 64 + lane_id(); if (tid < 257) *(LAS float*)(lds + fa::LDS_TAB + tid * 4) = G(P.b_rel)[tid * 32 + head] * LOG2E; }
            fa::attn_block<64, 64, true>(lds, F.wave, qkv + (size_t)qb * 256 * B_IN + head * 64, B_IN, qkv + 2048 + head * 64, B_IN, qkv + 4096 + head * 64, B_IN,
                                         ob + (size_t)qb * 256 * DM + head * 64, DM, 4 * qb, 8, 0.125f * LOG2E, G(P.pos));
        }
    }
    GRID_BAR();
    run_gemm<pg8::EpiResid, pg8::BMapPlain>(F, ob, DM, (const bf16_t*)(ws + WB_OUT), DM, DM, DM, pg8::EpiResid{h, h, DM});
    GRID_BAR();
}

struct SelUq { static __device__ __forceinline__ bool tile_any(int) { return true; }
               static __device__ __forceinline__ int j0(int col0) { const int r = col0 % 192; return r >= 128 ? ((r - 128) >> 1) : -1; } };
__device__ __forceinline__ void c_mid(const Frame& F, KP P) {
    unsigned char* ws = G(P.ws); const int lane = lane_id();
    const bf16_t* cd = (const bf16_t*)(ws + MC_CD); bf16_t* cqn = (bf16_t*)(ws + MC_CQN); bf16_t* ckvn = (bf16_t*)(ws + MC_CKVN); bf16_t* kb = (bf16_t*)(ws + MC_K);
    const f32x2* cs = (const f32x2*)(ws + WS_CS);
    const f32x4 gq0 = *(const f32x4*)(G(P.c_qn) + 8 * lane), gq1 = *(const f32x4*)(G(P.c_qn) + 8 * lane + 4), gk0 = *(const f32x4*)(G(P.c_kvn) + 8 * lane), gk1 = *(const f32x4*)(G(P.c_kvn) + 8 * lane + 4);
    for (int row = F.gw; row < SEQ; row += F.NGW) {
        const bf16_t* r = cd + (size_t)row * C_DOWNP;
        const u32x4 a = *(const u32x4*)(r + 8 * lane), b = *(const u32x4*)(r + 512 + 8 * lane);
        float x[8] = {bf_lo(a.x), bf_hi(a.x), bf_lo(a.y), bf_hi(a.y), bf_lo(a.z), bf_hi(a.z), bf_lo(a.w), bf_hi(a.w)};
        float y[8] = {bf_lo(b.x), bf_hi(b.x), bf_lo(b.y), bf_hi(b.y), bf_lo(b.z), bf_hi(b.z), bf_lo(b.w), bf_hi(b.w)};
        float sx = 0.f, sy = 0.f;
#pragma unroll
        for (int i = 0; i < 8; ++i) { sx += x[i] * x[i]; sy += y[i] * y[i]; }
        const float rq = 1.0f / sqrtf(wave_sum(sx) * (1.f / 512.f) + EPS), rk = 1.0f / sqrtf(wave_sum(sy) * (1.f / 512.f) + EPS);
        u32x4 wq, wk;
        wq.x = pk2(x[0] * rq * gq0[0], x[1] * rq * gq0[1]); wq.y = pk2(x[2] * rq * gq0[2], x[3] * rq * gq0[3]); wq.z = pk2(x[4] * rq * gq1[0], x[5] * rq * gq1[1]); wq.w = pk2(x[6] * rq * gq1[2], x[7] * rq * gq1[3]);
        wk.x = pk2(y[0] * rk * gk0[0], y[1] * rk * gk0[1]); wk.y = pk2(y[2] * rk * gk0[2], y[3] * rk * gk0[3]); wk.z = pk2(y[4] * rk * gk1[0], y[5] * rk * gk1[1]); wk.w = pk2(y[6] * rk * gk1[2], y[7] * rk * gk1[3]);
        *(u32x4*)(cqn + (size_t)row * 512 + 8 * lane) = wq; *(u32x4*)(ckvn + (size_t)row * 512 + 8 * lane) = wk;
        if (lane < 32) { const float x1 = bf_lo((unsigned)r[1024 + lane]), x2 = bf_lo((unsigned)r[1024 + 32 + lane]); const f32x2 c = cs[(size_t)row * 32 + lane];
            const unsigned w = pk2(x1 * c.x - x2 * c.y, x1 * c.y + x2 * c.x);
#pragma unroll
            for (int hd = 0; hd < 16; ++hd) *(unsigned*)(kb + (size_t)row * 3072 + hd * 192 + 128 + 2 * lane) = w; }
    }
}
__device__ __forceinline__ void mixer_c(const Frame& F, KP P, const XcdBarrier& bar) {
    unsigned char* ws = G(P.ws);
    float* h = (float*)(ws + WS_H); bf16_t* hn = (bf16_t*)(ws + WS_HN);
    bf16_t* cd = (bf16_t*)(ws + MC_CD); bf16_t* cqn = (bf16_t*)(ws + MC_CQN); bf16_t* ckvn = (bf16_t*)(ws + MC_CKVN);
    bf16_t* qb_ = (bf16_t*)(ws + MC_Q); bf16_t* kb = (bf16_t*)(ws + MC_K); bf16_t* vb = (bf16_t*)(ws + MC_V); bf16_t* ob = (bf16_t*)(ws + MC_O);
    norm_rows<false>(F, h, G(P.attn_norm) + 2 * DM, hn);
    GRID_BAR();
    run_gemm<pg8::EpiBf16, pg8::BMapPerm>(F, hn, DM, (const bf16_t*)(ws + WC_DOWN), DM, DM, C_DOWNP, pg8::EpiBf16{cd, C_DOWNP});
    GRID_BAR();
    c_mid(F, P);
    GRID_BAR();
    run_gemm<pg8::EpiRope<SelUq>, pg8::BMapPerm>(F, cqn, 512, (const bf16_t*)(ws + WC_UQ), 512, 512, C_UQ, pg8::EpiRope<SelUq>{qb_, C_UQ, (const f32x2*)(ws + WS_CS), nullptr});
    run_gemm<pg8::EpiUkv, pg8::BMapPerm>(F, ckvn, 512, (const bf16_t*)(ws + WC_UKV), 512, 512, C_UKV, pg8::EpiUkv{kb, vb});
    GRID_BAR();
    {
        const int vcu = vcu_of(F); LAS char* lds = (LAS char*)F.lds;
        const float c2 = 0.07216878364870322f * LOG2E;
        for (int rep_ = 0; rep_ < REP_MLA; ++rep_)
        for (int it = vcu; it < 256; it += F.G) {
            const int head = it >> 4, x = it & 15;
#pragma unroll 1
            for (int pass = 0; pass < 2; ++pass) { const int qb = pass ? 31 - x : x;
                fa::attn_block<192, 128, false>(lds, F.wave, qb_ + (size_t)qb * 256 * 3072 + head * 192, 3072, kb + head * 192, 3072, vb + head * 128, 2048,
                                                ob + (size_t)qb * 256 * DM + head * 128, DM, 4 * qb, 1 << 20, c2, G(P.pos)); }
        }
    }
    GRID_BAR();
    run_gemm<pg8::EpiResid, pg8::BMapPlain>(F, ob, DM, (const bf16_t*)(ws + WC_OUT), DM, DM, DM, pg8::EpiResid{h, h, DM});
    GRID_BAR();
}
struct SelAin { static __device__ __forceinline__ bool tile_any(int pn) { return pn >= 12; }
                static __device__ __forceinline__ int j0(int col0) { return (col0 >= AQI_OFF && col0 < AWI_OFF && (col0 & 127) < 64) ? ((col0 & 127) >> 1) : -1; } };
namespace pg8 {
struct IdxOrder {
    int G, c;
    static constexpr int NUNITS = 8448;
    __device__ bool next(int i, Unit& u) const {
        const int L = i * G + c; if (L >= NUNITS) return false;
        int g = 0;
#pragma unroll
        for (int bstep = 16; bstep >= 1; bstep >>= 1) if (8 * (g + bstep) * (g + bstep + 1) <= L) g += bstep;
        const int rem = L - 8 * g * (g + 1); u.pn = 16 * g + rem / (g + 1); u.pm = rem % (g + 1); u.seq = i; return true;
    }
    __device__ __forceinline__ long a_off(const Unit& u, int lda) const { return (long)u.pm * BM * lda; }
    __device__ __forceinline__ long b_off(const Unit& u, int ldb) const { return (long)u.pn * 16 * ldb; }
};
struct BMapIdx { static __device__ __forceinline__ long off(int h, int R, int ldb) { const int ql = 4 * (R >> 5) + ((R >> 2) & 3), hd = 8 * h + 4 * ((R >> 4) & 1) + (R & 3); return (long)ql * ldb + hd * 128; } };
struct EpiIdx {
    const bf16_t* wi; int ldw; bf16_t* SC; LAS char* stg;
    __device__ __forceinline__ void pre(const Unit& u, int wave, int lane) const {
        if (wave == 0) __builtin_amdgcn_global_load_lds((const unsigned*)(wi + (size_t)(u.pn * 16 + ((lane & 31) >> 1)) * ldw + (lane & 1) * 8), (LAS unsigned*)(stg + 8192 + (u.seq & 1) * 1024), 16, 0, 0); }
    __device__ __forceinline__ void operator()(const f32x4 (&acc)[2][2][4][2], const Unit& u, int wr, int wc, int fr_, int fq) const {
        int fr = fr_; asm volatile("" : "+v"(fr));
        const LAS u32x4* wl = (const LAS u32x4*)(stg + 8192 + (u.seq & 1) * 1024 + (4 * wc + fq) * 32); const u32x4 w0 = wl[0], w1 = wl[1];
        const float wv[16] = {bf_lo(w0.x), bf_hi(w0.x), bf_lo(w0.y), bf_hi(w0.y), bf_lo(w0.z), bf_hi(w0.z), bf_lo(w0.w), bf_hi(w0.w),
                              bf_lo(w1.x), bf_hi(w1.x), bf_lo(w1.y), bf_hi(w1.y), bf_lo(w1.z), bf_hi(w1.z), bf_lo(w1.w), bf_hi(w1.w)};
        LAS unsigned short* srow = (LAS unsigned short*)stg + (4 * wc + fq) * 256 + wr * 64 + fr;
#pragma unroll
        for (int ai = 0; ai < 2; ++ai)
#pragma unroll
            for (int m = 0; m < 4; ++m) { float s = 0.f;
#pragma unroll
                for (int bj = 0; bj < 2; ++bj)
#pragma unroll
                    for (int n = 0; n < 2; ++n)
#pragma unroll
                        for (int e = 0; e < 4; ++e) s = fmaf(wv[8 * bj + 4 * n + e], fmaxf(acc[ai][bj][m][n][e], 0.f), s);
                srow[ai * HALF + m * 16] = (unsigned short)f2bf(s); }
        asm volatile("s_waitcnt lgkmcnt(0)" ::: "memory"); __builtin_amdgcn_s_barrier(); asm volatile("" ::: "memory");
        const int tid = (wr * 4 + wc) * 64 + fq * 16 + fr, r = tid >> 5, ch = tid & 31;
        const u32x4 v = *(const LAS u32x4*)(stg + r * 512 + ch * 16);
        *(u32x4*)(SC + (size_t)(u.pn * 16 + r) * SEQ + u.pm * BM + ch * 8) = v;
    }
};
}

__device__ __forceinline__ unsigned fkey(float x) { const unsigned u = __float_as_uint(x); return u ^ ((u >> 31) ? 0xFFFFFFFFu : 0x80000000u); }
__device__ __forceinline__ void topk_rows(const Frame& F, const float* SC, int* IDX) {
    const int lane = lane_id();
    LAS unsigned* hist = (LAS unsigned*)(F.lds + F.wave * 1024);
    const unsigned long long ltmask = (1ull << lane) - 1ull;
    for (int q = F.gw; q < SEQ; q += F.NGW) {
        const int n = 64 * ((q >> 6) + 1);
        int* out = IDX + (size_t)q * TOPK;
        if (n <= TOPK) { for (int i = lane; i < TOPK; i += 64) out[i] = i < n ? i : -1; continue; }
        const float* row = SC + (size_t)q * SEQ;
        unsigned prefix = 0u; int kneed = TOPK;
#pragma unroll 1
        for (int pass = 0; pass < 4; ++pass) {
            const int shift = 24 - 8 * pass;
            hist[lane] = 0u; hist[lane + 64] = 0u; hist[lane + 128] = 0u; hist[lane + 192] = 0u;
            LDS_WAIT();
            for (int i = lane * 4; i < n; i += 256) { const f32x4 v = *(const f32x4*)(row + i);
#pragma unroll
                for (int e = 0; e < 4; ++e) { const unsigned u = fkey(v[e]);
                    if (pass == 0 || (u >> (shift + 8)) == prefix) __hip_atomic_fetch_add(hist + ((u >> shift) & 255u), 1u, __ATOMIC_RELAXED, __HIP_MEMORY_SCOPE_WORKGROUP); } }
            LDS_WAIT();
            const int c0 = (int)hist[255 - 4 * lane], c1 = (int)hist[254 - 4 * lane], c2 = (int)hist[253 - 4 * lane], c3 = (int)hist[252 - 4 * lane];
            const int s = c0 + c1 + c2 + c3; int incl = s;
#pragma unroll
            for (int o = 1; o < 64; o <<= 1) { const int t = __shfl_up(incl, o); if (lane >= o) incl += t; }
            const int excl = incl - s;
            const bool mine = (excl < kneed) && (kneed <= incl);
            int digit = 0, above = 0;
            if (mine) { int cum = excl;
                if (cum + c0 >= kneed) { digit = 255 - 4 * lane; above = cum; }
                else { cum += c0; if (cum + c1 >= kneed) { digit = 254 - 4 * lane; above = cum; }
                    else { cum += c1; if (cum + c2 >= kneed) { digit = 253 - 4 * lane; above = cum; } else { cum += c2; digit = 252 - 4 * lane; above = cum; } } } }
            const unsigned long long mm = __ballot(mine); const int src = mm ? (int)__builtin_ctzll(mm) : 0;
            digit = __shfl(digit, src); above = __shfl(above, src);
            prefix = (prefix << 8) | (unsigned)digit; kneed -= above;
            LDS_WAIT();
        }
        int base = 0, tbase = 0;
        for (int i0 = 0; i0 < n; i0 += 256) { const int i = i0 + lane * 4; const bool ok = i < n;
            f32x4 v = (f32x4){0.f, 0.f, 0.f, 0.f}; if (ok) v = *(const f32x4*)(row + i);
#pragma unroll
            for (int e = 0; e < 4; ++e) { const unsigned u = fkey(v[e]); const bool gt = ok && u > prefix, eq = ok && u == prefix;
                const unsigned long long me = __ballot(eq);
                const bool sel = gt || (eq && (tbase + (int)__builtin_popcountll(me & ltmask)) < kneed);
                const unsigned long long ms = __ballot(sel);
                if (sel) { const int p = base + (int)__builtin_popcountll(ms & ltmask); if (p < TOPK) out[p] = i + e; }
                base += (int)__builtin_popcountll(ms); tbase += (int)__builtin_popcountll(me); } }
    }
}


__device__ __forceinline__ unsigned skey16(unsigned x) { return x ^ ((x & 0x8000u) ? 0xFFFFu : 0x8000u); }
template <int NV>
__device__ __forceinline__ void topk_row_regs(const bf16_t* row, int n, int* out, LAS unsigned* hist, int lane) {
    const unsigned long long ltmask = (1ull << lane) - 1ull;
    unsigned u[NV][4];
#pragma unroll
    for (int j = 0; j < NV; ++j) { const int i = 8 * (64 * j + lane); const bool ok = i < n; const u32x4 v = *(const u32x4*)(row + (ok ? i : 0));
#pragma unroll
        for (int e = 0; e < 4; ++e) { const unsigned w = v[e]; u[j][e] = ok ? (w ^ ((((w >> 15) & 0x00010001u) * 0x7FFFu) | 0x80008000u)) : 0u; } }
#define TK_KEY(j_, e_) (((e_) & 1) ? (u[j_][(e_) >> 1] >> 16) : (u[j_][(e_) >> 1] & 0xFFFFu))
    unsigned prefix = 0u; int kneed = TOPK;
#pragma unroll 1
    for (int pass = 0; pass < 2; ++pass) {
#pragma unroll
        for (int k = 0; k < 8; ++k) ((LAS u32x4*)hist)[lane + 64 * k] = (u32x4){0u, 0u, 0u, 0u};
        LDS_WAIT();
#pragma unroll
        for (int j = 0; j < NV; ++j)
#pragma unroll
            for (int e = 0; e < 8; ++e) { const unsigned x = TK_KEY(j, e); const bool m = pass == 0 ? (x != 0u) : ((x >> 5) == prefix);
                if (m) __hip_atomic_fetch_add(hist + (pass == 0 ? (x >> 5) : (x & 31u)), 1u, __ATOMIC_RELAXED, __HIP_MEMORY_SCOPE_WORKGROUP); }
        LDS_WAIT();
        int s = 0;
#pragma unroll
        for (int k = 0; k < 8; ++k) { const u32x4 w = ((const LAS u32x4*)(hist + 2016 - 32 * lane))[k]; s += (int)((w.x + w.y) + (w.z + w.w)); }
        int incl = s;
#pragma unroll
        for (int o = 1; o < 64; o <<= 1) { const int t = __shfl_up(incl, o); if (lane >= o) incl += t; }
        const int excl = incl - s;
        const unsigned long long m1 = __ballot(excl < kneed && kneed <= incl); const int L1 = m1 ? (int)__builtin_ctzll(m1) : 0;
        const int exclL = __shfl(excl, L1);
        const int c = lane < 32 ? (int)hist[2047 - 32 * L1 - lane] : 0; int incl2 = c;
#pragma unroll
        for (int o = 1; o < 64; o <<= 1) { const int t = __shfl_up(incl2, o); if (lane >= o) incl2 += t; }
        const int excl2 = incl2 - c;
        const unsigned long long m2 = __ballot(exclL + excl2 < kneed && kneed <= exclL + incl2); const int L2 = m2 ? (int)__builtin_ctzll(m2) : 0;
        const unsigned digit = (unsigned)(2047 - 32 * L1 - L2);
        kneed -= exclL + __shfl(excl2, L2);
        prefix = pass == 0 ? digit : ((prefix << 5) | digit);
        LDS_WAIT();
    }
    int base = 0;
#pragma unroll
    for (int j = 0; j < NV; ++j)
#pragma unroll
        for (int e = 0; e < 8; ++e) { const bool gt = TK_KEY(j, e) > prefix; const unsigned long long mg = __ballot(gt);
            if (mg) { if (gt) out[base + (int)__builtin_popcountll(mg & ltmask)] = 8 * (64 * j + lane) + e; base += (int)__builtin_popcountll(mg); } }
#pragma unroll
    for (int j = 0; j < NV; ++j)
#pragma unroll
        for (int e = 0; e < 8; ++e) { const bool eq = TK_KEY(j, e) == prefix; const unsigned long long me = __ballot(eq);
            if (me) { if (eq) { const int p = base + (int)__builtin_popcountll(me & ltmask); if (p < TOPK) out[p] = 8 * (64 * j + lane) + e; } base += (int)__builtin_popcountll(me); } }
#undef TK_KEY
}
__device__ __forceinline__ void topk_rows2(const Frame& F, const bf16_t* SC, int* IDX) {
    const int lane = lane_id();
    LAS unsigned* hist = (LAS unsigned*)(F.lds + F.wave * 16384);
    for (int q = F.gw; q < SEQ; q += F.NGW) {
        const int n = 64 * ((q >> 6) + 1);
        int* out = IDX + (size_t)q * TOPK;
        if (n <= TOPK) { for (int i = lane; i < TOPK; i += 64) out[i] = i < n ? i : -1; continue; }
        const bf16_t* row = SC + (size_t)q * SEQ;
        if (n <= 2048) topk_row_regs<4>(row, n, out, hist, lane);
        else if (n <= 4096) topk_row_regs<8>(row, n, out, hist, lane);
        else if (n <= 6144) topk_row_regs<12>(row, n, out, hist, lane);
        else topk_row_regs<16>(row, n, out, hist, lane);
    }
}

__device__ __forceinline__ int t5_bucket(int rel) {
    const int n = rel < 0 ? -rel : rel; int b = rel > 0 ? 16 : 0;
    if (n < 8) return b + n;
    int large = 8 + (int)(__log2f((float)n * 0.125f) * (8.0f / 7.0f)); large = large > 15 ? 15 : large;
    return b + large;
}
__device__ __forceinline__ void sparse_attn(const Frame& F, KP P, const bf16_t* qkvi, const int* IDX, bf16_t* O) {
    const int lane = lane_id(), g = lane >> 4, c = lane & 15;
    LAS float* lg = (LAS float*)(F.lds + F.wave * 16384);
    LAS float* t5l = (LAS float*)(F.lds + MISC_OFF + 1024);
    __syncthreads();
    { const int tid = F.wave * 64 + lane; t5l[tid] = G(P.t5)[tid]; }
    __syncthreads();
    const float scale = 0.08838834764831845f;
    for (int q = F.gw; q < SEQ; q += F.NGW) {
        const int pq = G(P.pos)[q];
        float qf[4][8];
#pragma unroll
        for (int e = 0; e < 4; ++e) { const u32x4 w = *(const u32x4*)(qkvi + (size_t)q * A_INP + AQ_OFF + (4 * g + e) * 128 + 8 * c);
            qf[e][0] = bf_lo(w.x) * scale; qf[e][1] = bf_hi(w.x) * scale; qf[e][2] = bf_lo(w.y) * scale; qf[e][3] = bf_hi(w.y) * scale;
            qf[e][4] = bf_lo(w.z) * scale; qf[e][5] = bf_hi(w.z) * scale; qf[e][6] = bf_lo(w.w) * scale; qf[e][7] = bf_hi(w.w) * scale; }
        int id[4];
#pragma unroll
        for (int kk = 0; kk < 4; ++kk) id[kk] = IDX[(size_t)q * TOPK + kk * 64 + lane];
#pragma unroll
        for (int kk = 0; kk < 4; ++kk) {
#pragma unroll 4
            for (int i = 0; i < 64; ++i) {
                const int kidx = __builtin_amdgcn_readlane(id[kk], i); const int key = kk * 64 + i;
                if (kidx < 0) { if (c == 0) {
#pragma unroll
                        for (int e = 0; e < 4; ++e) lg[(4 * g + e) * 256 + key] = -__builtin_inff(); }
                    continue; }
                const u32x4 w = *(const u32x4*)(qkvi + (size_t)kidx * A_INP + AK_OFF + g * 128 + 8 * c);
                const float kf[8] = {bf_lo(w.x), bf_hi(w.x), bf_lo(w.y), bf_hi(w.y), bf_lo(w.z), bf_hi(w.z), bf_lo(w.w), bf_hi(w.w)};
                float pr[4];
#pragma unroll
                for (int e = 0; e < 4; ++e) { float s = 0.f;
#pragma unroll
                    for (int j = 0; j < 8; ++j) s = fmaf(qf[e][j], kf[j], s);
                    s += __shfl_xor(s, 1); s += __shfl_xor(s, 2); s += __shfl_xor(s, 4); s += __shfl_xor(s, 8); pr[e] = s; }
                const int bk = t5_bucket(G(P.pos)[kidx] - pq);
                if (c == 0) {
#pragma unroll
                    for (int e = 0; e < 4; ++e) lg[(4 * g + e) * 256 + key] = pr[e] + t5l[bk * 16 + 4 * g + e]; }
            }
        }
        LDS_WAIT();
#pragma unroll 1
        for (int hd = 0; hd < 16; ++hd) {
            const float x0 = lg[hd * 256 + lane], x1 = lg[hd * 256 + 64 + lane], x2 = lg[hd * 256 + 128 + lane], x3 = lg[hd * 256 + 192 + lane];
            const float m = wave_max(fmaxf(fmaxf(x0, x1), fmaxf(x2, x3)));
            const float e0 = __expf(x0 - m), e1 = __expf(x1 - m), e2 = __expf(x2 - m), e3 = __expf(x3 - m);
            const float inv = 1.0f / wave_sum((e0 + e1) + (e2 + e3));
            lg[hd * 256 + lane] = e0 * inv; lg[hd * 256 + 64 + lane] = e1 * inv; lg[hd * 256 + 128 + lane] = e2 * inv; lg[hd * 256 + 192 + lane] = e3 * inv;
        }
        LDS_WAIT();
        float acc[4][8];
#pragma unroll
        for (int e = 0; e < 4; ++e)
#pragma unroll
            for (int j = 0; j < 8; ++j) acc[e][j] = 0.f;
#pragma unroll
        for (int kk = 0; kk < 4; ++kk) {
#pragma unroll 4
            for (int i = 0; i < 64; ++i) {
                const int kidx = __builtin_amdgcn_readlane(id[kk], i); const int key = kk * 64 + i;
                if (kidx < 0) continue;
                const u32x4 w = *(const u32x4*)(qkvi + (size_t)kidx * A_INP + AV_OFF + g * 128 + 8 * c);
                const float vf[8] = {bf_lo(w.x), bf_hi(w.x), bf_lo(w.y), bf_hi(w.y), bf_lo(w.z), bf_hi(w.z), bf_lo(w.w), bf_hi(w.w)};
#pragma unroll
                for (int e = 0; e < 4; ++e) { const float p = lg[(4 * g + e) * 256 + key];
#pragma unroll
                    for (int j = 0; j < 8; ++j) acc[e][j] = fmaf(p, vf[j], acc[e][j]); }
            }
        }
#pragma unroll
        for (int e = 0; e < 4; ++e) { u32x4 w; w.x = pk2(acc[e][0], acc[e][1]); w.y = pk2(acc[e][2], acc[e][3]); w.z = pk2(acc[e][4], acc[e][5]); w.w = pk2(acc[e][6], acc[e][7]);
            *(u32x4*)(O + (size_t)q * DM + (4 * g + e) * 128 + 8 * c) = w; }
        LDS_WAIT();
    }
}


typedef short s16x4v __attribute__((ext_vector_type(4)));
#define SA_COPY16(g, l) (*(LAS u32x4*)((l) + lane * 16) = *(const u32x4*)(g))
constexpr int SA_VBUF = 4608, SA_RING = 3 * SA_VBUF, SA_AUX_OFF = 8 * SA_RING, SA_AUX = 1280;
__device__ __forceinline__ void sparse_attn2(const Frame& F, KP P, const bf16_t* qkvi, const int* IDX, bf16_t* O) {
    const int lane = lane_id(), hc = lane & 15, rq = lane >> 4;
    LAS char* ring = (LAS char*)F.lds + F.wave * SA_RING;
    LAS int* rowoff = (LAS int*)((LAS char*)F.lds + SA_AUX_OFF + F.wave * SA_AUX);
    LAS unsigned char* bkt = (LAS unsigned char*)(rowoff + 256);
    LAS float* t5l = (LAS float*)((LAS char*)F.lds + MISC_OFF + 1024);
    __syncthreads();
    { const int tid = F.wave * 64 + lane; t5l[tid] = G(P.t5)[tid] * LOG2E; if (tid < 16) t5l[512 + tid] = -__builtin_inff(); }
    __syncthreads();
    const float c2 = 0.08838834764831845f * LOG2E;
    constexpr int LDB = A_INP * 2;
    const int trl = rq * 1152 + ((hc & 3) >> 1) * 64 + (hc >> 2) * 16 + (hc & 1) * 8;
    for (int q = F.gw; q < SEQ; q += F.NGW) {
        const int pq = G(P.pos)[q];
#pragma unroll
        for (int k4 = 0; k4 < 4; ++k4) { const int slot = k4 * 64 + lane; const int kidx = IDX[(size_t)q * TOPK + slot]; const bool ok = kidx >= 0;
            rowoff[slot] = ok ? kidx * LDB : 0; bkt[slot] = (unsigned char)(ok ? t5_bucket(G(P.pos)[ok ? kidx : 0] - pq) : 32); }
        LDS_WAIT();
#pragma unroll 1
        for (int g = 0; g < 4; ++g) {
            bf16x8 qf[4];
#pragma unroll
            for (int kk = 0; kk < 4; ++kk) { qf[kk] = (bf16x8){0, 0, 0, 0, 0, 0, 0, 0};
                if (hc < 4) qf[kk] = *(const bf16x8*)(qkvi + (size_t)q * A_INP + AQ_OFF + (4 * g + hc) * 128 + 32 * kk + 8 * rq); }
            const char* kbase = (const char*)qkvi + (AK_OFF + g * 128) * 2 + rq * 16;
            f32x4 S[16]; bf16x8 kq[4][4];
#pragma unroll
            for (int pt = 0; pt < 4; ++pt)
#pragma unroll
                for (int kk = 0; kk < 4; ++kk) kq[pt][kk] = *(const bf16x8*)(kbase + rowoff[16 * pt + hc] + kk * 64);
#pragma unroll
            for (int t = 0; t < 16; ++t) {
                f32x4 a = (f32x4){0.f, 0.f, 0.f, 0.f};
#pragma unroll
                for (int kk = 0; kk < 4; ++kk) a = __builtin_amdgcn_mfma_f32_16x16x32_bf16(kq[t % 4][kk], qf[kk], a, 0, 0, 0);
                S[t] = a;
                if (t + 4 < 16) {
#pragma unroll
                    for (int kk = 0; kk < 4; ++kk) kq[t % 4][kk] = *(const bf16x8*)(kbase + rowoff[16 * (t + 4) + hc] + kk * 64); } }
            const char* vbase = (const char*)qkvi + (AV_OFF + g * 128) * 2 + (lane >> 2) * 16;
            u32x4 vr[4][4];
#define SA_VLOAD(t) do { _Pragma("unroll") for (int j_ = 0; j_ < 4; ++j_) vr[(t) % 4][j_] = *(const u32x4*)(vbase + rowoff[16 * (t) + 4 * j_ + (lane & 3)]); } while (0)
#define SA_VSTORE(t) do { _Pragma("unroll") for (int j_ = 0; j_ < 4; ++j_) *(LAS u32x4*)(ring + ((t) % 2) * SA_VBUF + j_ * 1152 + lane * 16) = vr[(t) % 4][j_]; } while (0)
            SA_VLOAD(0); SA_VLOAD(1); SA_VLOAD(2); SA_VLOAD(3);
            float m = -__builtin_inff();
#pragma unroll
            for (int t = 0; t < 16; ++t) { const unsigned w = *(const LAS unsigned*)(bkt + 16 * t + 4 * rq);
#pragma unroll
                for (int r = 0; r < 4; ++r) { const int b = (w >> (8 * r)) & 255; S[t][r] = fmaf(S[t][r], c2, t5l[b * 16 + 4 * g + (hc & 3)]); m = fmaxf(m, S[t][r]); } }
            m = fmaxf(m, __shfl_xor(m, 16)); m = fmaxf(m, __shfl_xor(m, 32));
            float l = 0.f; s16x4v pf[16];
#pragma unroll
            for (int t = 0; t < 16; ++t) { float e[4];
#pragma unroll
                for (int r = 0; r < 4; ++r) { e[r] = __builtin_amdgcn_exp2f(S[t][r] - m); l += e[r]; }
                u32x2 w; w.x = cvt_pk_bf16(e[0], e[1]); w.y = cvt_pk_bf16(e[2], e[3]); pf[t] = __builtin_bit_cast(s16x4v, w); }
            l += __shfl_xor(l, 16); l += __shfl_xor(l, 32);
            f32x4 o[8];
#pragma unroll
            for (int dt = 0; dt < 8; ++dt) o[dt] = (f32x4){0.f, 0.f, 0.f, 0.f};
#pragma unroll
            for (int t = 0; t < 16; ++t) {
                SA_VSTORE(t);
                if (t + 4 < 16) SA_VLOAD(t + 4);
                const LAS char* vb = ring + (t % 2) * SA_VBUF + trl;
#pragma unroll
                for (int dt = 0; dt < 8; ++dt) { const s16x4v a = __builtin_bit_cast(s16x4v, __builtin_amdgcn_ds_read_tr16_b64_v4i16((LAS fa::v4i16_t*)(vb + dt * 128)));
                    o[dt] = __builtin_amdgcn_mfma_f32_16x16x16bf16_1k(a, pf[t], o[dt], 0, 0, 0); }
            }
#undef SA_VLOAD
#undef SA_VSTORE
            const float rl = 1.0f / l;
            if (hc < 4) {
#pragma unroll
                for (int dt = 0; dt < 8; ++dt) { u32x2 w; w.x = cvt_pk_bf16(o[dt][0] * rl, o[dt][1] * rl); w.y = cvt_pk_bf16(o[dt][2] * rl, o[dt][3] * rl);
                    *(u32x2*)(O + (size_t)q * DM + (4 * g + hc) * 128 + 16 * dt + 4 * rq) = w; } }
        }
        LDS_WAIT();
    }
}


__device__ __forceinline__ unsigned cvt_pk_bf16_s(float lo, float hi) { unsigned r; asm("v_cvt_pk_bf16_f32 %0, %1, %2" : "=v"(r) : "v"(lo), "v"(hi)); return r; }
__device__ __forceinline__ void sparse_attn3(const Frame& F, KP P, const bf16_t* qkvi, const unsigned char* kv8, const int* IDX, bf16_t* O, const bool hot = false) {
    const int lane = lane_id(), hc = lane & 15, rq = lane >> 4;
    LAS char* ring = (LAS char*)F.lds + F.wave * SA_RING;
    LAS int* rowoff = (LAS int*)((LAS char*)F.lds + SA_AUX_OFF + F.wave * SA_AUX);
    LAS unsigned char* bkt = (LAS unsigned char*)(rowoff + 256);
    LAS float* t5l = (LAS float*)((LAS char*)F.lds + MISC_OFF + 1024);
    __syncthreads();
    { const int tid = F.wave * 64 + lane; t5l[tid] = G(P.t5)[tid] * LOG2E; if (tid < 16) t5l[512 + tid] = -__builtin_inff(); }
    __syncthreads();
    const float c2 = 0.08838834764831845f * LOG2E;
    const int trl = rq * 1152 + ((hc & 3) >> 1) * 64 + (hc >> 2) * 16 + (hc & 1) * 8;
    const int vst = ((lane & 7) >> 2) * 1152 + (2 * (lane >> 3)) * 64 + (lane & 3) * 16;
    const int* pos = G(P.pos);
#define SA_KLOAD(gg, t) do { _Pragma("unroll") for (int L_ = 0; L_ < 2; ++L_) kq[(t) % 6][L_] = *(const u32x4*)(kv8 + (size_t)(gg) * (SEQ * 128) + rq * 16 + rowoff[16 * (t) + hc] + 64 * L_); } while (0)
    for (int q = F.gw; q < SEQ; q += F.NGW) {
        const int pq = pos[q];
#pragma unroll
        for (int k4 = 0; k4 < 4; ++k4) { const int slot = k4 * 64 + lane; const int kidx = IDX[(size_t)q * TOPK + slot]; const bool ok = kidx >= 0;
            rowoff[slot] = ok ? (hot ? (kidx & 255) : kidx) * 128 : 0; bkt[slot] = (unsigned char)(ok ? t5_bucket(pos[ok ? kidx : 0] - pq) : 32); }
        LDS_WAIT();
        u32x4 kq[6][2];
        SA_KLOAD(0, 0); SA_KLOAD(0, 1); SA_KLOAD(0, 2); SA_KLOAD(0, 3); SA_KLOAD(0, 4); SA_KLOAD(0, 5);
#pragma unroll 1
        for (int g = 0; g < 4; ++g) {
            long qf[4];
#pragma unroll
            for (int L = 0; L < 2; ++L) { u32x4 a = (u32x4){0u, 0u, 0u, 0u}, b = (u32x4){0u, 0u, 0u, 0u};
                if (hc < 4) { const bf16_t* qp = qkvi + (size_t)q * A_INP + AQ_OFF + (4 * g + hc) * 128 + 64 * L + 16 * rq; a = *(const u32x4*)qp; b = *(const u32x4*)(qp + 8); }
                int w0 = __builtin_amdgcn_cvt_pk_fp8_f32(bf_lo(a.x), bf_hi(a.x), 0, false); w0 = __builtin_amdgcn_cvt_pk_fp8_f32(bf_lo(a.y), bf_hi(a.y), w0, true);
                int w1 = __builtin_amdgcn_cvt_pk_fp8_f32(bf_lo(a.z), bf_hi(a.z), 0, false); w1 = __builtin_amdgcn_cvt_pk_fp8_f32(bf_lo(a.w), bf_hi(a.w), w1, true);
                int w2 = __builtin_amdgcn_cvt_pk_fp8_f32(bf_lo(b.x), bf_hi(b.x), 0, false); w2 = __builtin_amdgcn_cvt_pk_fp8_f32(bf_lo(b.y), bf_hi(b.y), w2, true);
                int w3 = __builtin_amdgcn_cvt_pk_fp8_f32(bf_lo(b.z), bf_hi(b.z), 0, false); w3 = __builtin_amdgcn_cvt_pk_fp8_f32(bf_lo(b.w), bf_hi(b.w), w3, true);
                qf[2 * L] = (long)(((unsigned long long)(unsigned)w1 << 32) | (unsigned)w0); qf[2 * L + 1] = (long)(((unsigned long long)(unsigned)w3 << 32) | (unsigned)w2); }
            f32x4 S[16];
#pragma unroll
            for (int t = 0; t < 16; ++t) {
                f32x4 a = (f32x4){0.f, 0.f, 0.f, 0.f};
#pragma unroll
                for (int L = 0; L < 2; ++L) { const u32x4 w = kq[t % 6][L];
                    a = __builtin_amdgcn_mfma_f32_16x16x32_fp8_fp8((long)(((unsigned long long)w.y << 32) | w.x), qf[2 * L], a, 0, 0, 0);
                    a = __builtin_amdgcn_mfma_f32_16x16x32_fp8_fp8((long)(((unsigned long long)w.w << 32) | w.z), qf[2 * L + 1], a, 0, 0, 0); }
                S[t] = a;
                if (t + 6 < 16) SA_KLOAD(g, t + 6); }
            const unsigned char* vbase = kv8 + (size_t)(4 + g) * (SEQ * 128) + (lane >> 3) * 16;
            u32x4 vr[6][2];
#define SA_VLOAD(t) do { _Pragma("unroll") for (int j_ = 0; j_ < 2; ++j_) vr[(t) % 6][j_] = *(const u32x4*)(vbase + rowoff[16 * (t) + 8 * j_ + (lane & 7)]); } while (0)
#define SA_CV(w_, lo_, hi_) do { const f32x2 f0_ = __builtin_amdgcn_cvt_pk_f32_fp8((int)(w_), false), f1_ = __builtin_amdgcn_cvt_pk_f32_fp8((int)(w_), true); lo_ = cvt_pk_bf16_s(f0_.x, f0_.y); hi_ = cvt_pk_bf16_s(f1_.x, f1_.y); } while (0)
#define SA_VSTORE(t) do { _Pragma("unroll") for (int j_ = 0; j_ < 2; ++j_) { const u32x4 w_ = vr[(t) % 6][j_]; u32x4 c0_, c1_; \
        SA_CV(w_.x, c0_.x, c0_.y); SA_CV(w_.y, c0_.z, c0_.w); SA_CV(w_.z, c1_.x, c1_.y); SA_CV(w_.w, c1_.z, c1_.w); \
        LAS char* d_ = ring + ((t) % 2) * SA_VBUF + j_ * 2304 + vst; *(LAS u32x4*)d_ = c0_; *(LAS u32x4*)(d_ + 64) = c1_; } } while (0)
            SA_VLOAD(0); SA_VLOAD(1); SA_VLOAD(2); SA_VLOAD(3); SA_VLOAD(4); SA_VLOAD(5);
            float m = -__builtin_inff();
#pragma unroll
            for (int t = 0; t < 16; ++t) { const unsigned w = *(const LAS unsigned*)(bkt + 16 * t + 4 * rq);
#pragma unroll
                for (int r = 0; r < 4; ++r) { const int b = (w >> (8 * r)) & 255; S[t][r] = fmaf(S[t][r], c2, t5l[b * 16 + 4 * g + (hc & 3)]); m = fmaxf(m, S[t][r]); } }
            m = fmaxf(m, __shfl_xor(m, 16)); m = fmaxf(m, __shfl_xor(m, 32));
            float l = 0.f; s16x4v pf[16];
#pragma unroll
            for (int t = 0; t < 16; ++t) { float e[4];
#pragma unroll
                for (int r = 0; r < 4; ++r) { e[r] = __builtin_amdgcn_exp2f(S[t][r] - m); l += e[r]; }
                u32x2 w; w.x = cvt_pk_bf16_s(e[0], e[1]); w.y = cvt_pk_bf16_s(e[2], e[3]); pf[t] = __builtin_bit_cast(s16x4v, w); }
            l += __shfl_xor(l, 16); l += __shfl_xor(l, 32);
            if (g < 3) { SA_KLOAD(g + 1, 0); SA_KLOAD(g + 1, 1); SA_KLOAD(g + 1, 2); SA_KLOAD(g + 1, 3); SA_KLOAD(g + 1, 4); SA_KLOAD(g + 1, 5); }
            f32x4 o[8];
#pragma unroll
            for (int dt = 0; dt < 8; ++dt) o[dt] = (f32x4){0.f, 0.f, 0.f, 0.f};
            SA_VSTORE(0); SA_VLOAD(6);
#pragma unroll
            for (int t = 0; t < 16; ++t) {
                const LAS char* vb = ring + (t % 2) * SA_VBUF + trl;
                s16x4v av[8];
#pragma unroll
                for (int dt = 0; dt < 8; ++dt) av[dt] = __builtin_bit_cast(s16x4v, __builtin_amdgcn_ds_read_tr16_b64_v4i16((LAS fa::v4i16_t*)(vb + dt * 128)));
                __builtin_amdgcn_sched_barrier(0);
                if (t + 1 < 16) SA_VSTORE(t + 1);
                if (t + 7 < 16) SA_VLOAD(t + 7);
                __builtin_amdgcn_sched_barrier(0);
#pragma unroll
                for (int dt = 0; dt < 8; ++dt) o[dt] = __builtin_amdgcn_mfma_f32_16x16x16bf16_1k(av[dt], pf[t], o[dt], 0, 0, 0);
            }
#undef SA_VLOAD
#undef SA_VSTORE
#undef SA_CV
            const float rl = 1.0f / l;
            if (hc < 4) {
#pragma unroll
                for (int dt = 0; dt < 8; ++dt) { u32x2 w; w.x = cvt_pk_bf16_s(o[dt][0] * rl, o[dt][1] * rl); w.y = cvt_pk_bf16_s(o[dt][2] * rl, o[dt][3] * rl);
                    *(u32x2*)(O + (size_t)q * DM + (4 * g + hc) * 128 + 16 * dt + 4 * rq) = w; } }
        }
        LDS_WAIT();
    }
#undef SA_KLOAD
}

#ifndef SA_MAPV
#define SA_MAPV 0
#endif
typedef int v2i32_t __attribute__((ext_vector_type(2)));
__device__ __forceinline__ void sparse_attn4(const Frame& F, KP P, const bf16_t* qkvi, const unsigned char* kv8, const int* IDX, bf16_t* O) {
    const int lane = lane_id(), hc = lane & 15, rq = lane >> 4;
    LAS char* ring = (LAS char*)F.lds + F.wave * SA_RING;
    LAS int* rowoff = (LAS int*)((LAS char*)F.lds + SA_AUX_OFF + F.wave * SA_AUX);
    LAS unsigned char* bkt = (LAS unsigned char*)(rowoff + 256);
    LAS float* t5l = (LAS float*)((LAS char*)F.lds + MISC_OFF + 1024);
    __syncthreads();
    { const int tid = F.wave * 64 + lane; t5l[tid] = G(P.t5)[tid] * LOG2E; if (tid < 16) t5l[512 + tid] = -__builtin_inff(); }
    __syncthreads();
    const float c2 = 0.08838834764831845f * LOG2E;
#if SA_MAPV == 0
    const int qp_ = hc >> 1, pp_ = hc & 1;
#else
    const int qp_ = hc & 7, pp_ = hc >> 3;
#endif
    const int rho_rd = ((qp_ & 3) | ((rq & 1) << 2)) | ((qp_ >> 2) << 3) | ((rq >> 1) << 4);
    const int trl = rho_rd * 144 + 8 * pp_;
    int vst[4];
#pragma unroll
    for (int jj = 0; jj < 4; ++jj) { const int sl = 8 * jj + (lane >> 3); vst[jj] = ((sl & 7) | ((sl >> 4) << 3) | (((sl >> 3) & 1) << 4)) * 144 + (lane & 7) * 16; }
    const int* pos = G(P.pos);
#define SA_KLOAD(gg, t) do { const unsigned char* kb_ = kv8 + (size_t)(gg) * (SEQ * 128); const unsigned ko_ = (unsigned)rowoff[16 * (t) + hc] + (unsigned)(rq * 16); \
        kq[(t) % 6][0] = *(const u32x4*)(kb_ + ko_); kq[(t) % 6][1] = *(const u32x4*)(kb_ + ko_ + 64u); } while (0)
    for (int q = F.gw; q < SEQ; q += F.NGW) {
        const int pq = pos[q];
#pragma unroll
        for (int k4 = 0; k4 < 4; ++k4) { const int slot = k4 * 64 + lane; const int kidx = IDX[(size_t)q * TOPK + slot]; const bool ok = kidx >= 0;
            rowoff[slot] = ok ? kidx * 128 : 0; bkt[slot] = (unsigned char)(ok ? t5_bucket(pos[ok ? kidx : 0] - pq) : 32); }
        LDS_WAIT();
        u32x4 kq[6][2];
        SA_KLOAD(0, 0); SA_KLOAD(0, 1); SA_KLOAD(0, 2); SA_KLOAD(0, 3); SA_KLOAD(0, 4); SA_KLOAD(0, 5);
#pragma unroll 1
        for (int g = 0; g < 4; ++g) {
            long qf[4];
#pragma unroll
            for (int L = 0; L < 2; ++L) { u32x4 a = (u32x4){0u, 0u, 0u, 0u}, b = (u32x4){0u, 0u, 0u, 0u};
                if (hc < 4) { const bf16_t* qp = qkvi + (size_t)q * A_INP + AQ_OFF + (4 * g + hc) * 128 + 64 * L + 16 * rq; a = *(const u32x4*)qp; b = *(const u32x4*)(qp + 8); }
                int w0 = __builtin_amdgcn_cvt_pk_fp8_f32(bf_lo(a.x), bf_hi(a.x), 0, false); w0 = __builtin_amdgcn_cvt_pk_fp8_f32(bf_lo(a.y), bf_hi(a.y), w0, true);
                int w1 = __builtin_amdgcn_cvt_pk_fp8_f32(bf_lo(a.z), bf_hi(a.z), 0, false); w1 = __builtin_amdgcn_cvt_pk_fp8_f32(bf_lo(a.w), bf_hi(a.w), w1, true);
                int w2 = __builtin_amdgcn_cvt_pk_fp8_f32(bf_lo(b.x), bf_hi(b.x), 0, false); w2 = __builtin_amdgcn_cvt_pk_fp8_f32(bf_lo(b.y), bf_hi(b.y), w2, true);
                int w3 = __builtin_amdgcn_cvt_pk_fp8_f32(bf_lo(b.z), bf_hi(b.z), 0, false); w3 = __builtin_amdgcn_cvt_pk_fp8_f32(bf_lo(b.w), bf_hi(b.w), w3, true);
                qf[2 * L] = (long)(((unsigned long long)(unsigned)w1 << 32) | (unsigned)w0); qf[2 * L + 1] = (long)(((unsigned long long)(unsigned)w3 << 32) | (unsigned)w2); }
            f32x4 S[16];
#pragma unroll
            for (int t = 0; t < 16; ++t) {
                f32x4 a = (f32x4){0.f, 0.f, 0.f, 0.f};
#pragma unroll
                for (int L = 0; L < 2; ++L) { const u32x4 w = kq[t % 6][L];
                    a = __builtin_amdgcn_mfma_f32_16x16x32_fp8_fp8((long)(((unsigned long long)w.y << 32) | w.x), qf[2 * L], a, 0, 0, 0);
                    a = __builtin_amdgcn_mfma_f32_16x16x32_fp8_fp8((long)(((unsigned long long)w.w << 32) | w.z), qf[2 * L + 1], a, 0, 0, 0); }
                S[t] = a;
                if (t + 6 < 16) SA_KLOAD(g, t + 6); }
            const unsigned char* vbase = kv8 + (size_t)(4 + g) * (SEQ * 128);
            u32x4 vr[3][4];
#define SA_VLOAD(s_) do { _Pragma("unroll") for (int jj_ = 0; jj_ < 4; ++jj_) vr[(s_) % 3][jj_] = *(const u32x4*)(vbase + ((unsigned)rowoff[32 * (s_) + 8 * jj_ + (lane >> 3)] + (unsigned)((lane & 7) * 16))); } while (0)
#define SA_VSTORE(s_) do { _Pragma("unroll") for (int jj_ = 0; jj_ < 4; ++jj_) *(LAS u32x4*)(ring + ((s_) % 2) * SA_VBUF + vst[jj_]) = vr[(s_) % 3][jj_]; } while (0)
            SA_VLOAD(0); SA_VLOAD(1); SA_VLOAD(2);
            float m = -__builtin_inff();
#pragma unroll
            for (int t = 0; t < 16; ++t) { const unsigned w = *(const LAS unsigned*)(bkt + 16 * t + 4 * rq);
#pragma unroll
                for (int r = 0; r < 4; ++r) { const int b = (w >> (8 * r)) & 255; S[t][r] = fmaf(S[t][r], c2, t5l[b * 16 + 4 * g + (hc & 3)]); m = fmaxf(m, S[t][r]); } }
            m = fmaxf(m, __shfl_xor(m, 16)); m = fmaxf(m, __shfl_xor(m, 32));
            m -= 8.0f;
            float l = 0.f; long pf8[8];
#pragma unroll
            for (int s = 0; s < 8; ++s) { float e[8];
#pragma unroll
                for (int r = 0; r < 4; ++r) { e[r] = __builtin_amdgcn_exp2f(S[2 * s][r] - m); e[4 + r] = __builtin_amdgcn_exp2f(S[2 * s + 1][r] - m); }
                l += ((e[0] + e[1]) + (e[2] + e[3])) + ((e[4] + e[5]) + (e[6] + e[7]));
                int w0 = __builtin_amdgcn_cvt_pk_fp8_f32(e[0], e[1], 0, false); w0 = __builtin_amdgcn_cvt_pk_fp8_f32(e[2], e[3], w0, true);
                int w1 = __builtin_amdgcn_cvt_pk_fp8_f32(e[4], e[5], 0, false); w1 = __builtin_amdgcn_cvt_pk_fp8_f32(e[6], e[7], w1, true);
                pf8[s] = (long)(((unsigned long long)(unsigned)w1 << 32) | (unsigned)w0); }
            l += __shfl_xor(l, 16); l += __shfl_xor(l, 32);
            if (g < 3) { SA_KLOAD(g + 1, 0); SA_KLOAD(g + 1, 1); SA_KLOAD(g + 1, 2); SA_KLOAD(g + 1, 3); SA_KLOAD(g + 1, 4); SA_KLOAD(g + 1, 5); }
            f32x4 o[8];
#pragma unroll
            for (int dt = 0; dt < 8; ++dt) o[dt] = (f32x4){0.f, 0.f, 0.f, 0.f};
            SA_VSTORE(0); SA_VLOAD(3);
#pragma unroll
            for (int s = 0; s < 8; ++s) {
                const LAS char* vb = ring + (s % 2) * SA_VBUF + trl;
                v2i32_t av[8];
#pragma unroll
                for (int dt = 0; dt < 8; ++dt) av[dt] = __builtin_amdgcn_ds_read_tr8_b64_v2i32((LAS v2i32_t*)(vb + dt * 16));
                __builtin_amdgcn_sched_barrier(0);
                if (s + 1 < 8) SA_VSTORE(s + 1);
                if (s + 4 < 8) SA_VLOAD(s + 4);
                __builtin_amdgcn_sched_barrier(0);
#pragma unroll
                for (int dt = 0; dt < 8; ++dt) o[dt] = __builtin_amdgcn_mfma_f32_16x16x32_fp8_fp8((long)(((unsigned long long)(unsigned)av[dt].y << 32) | (unsigned)av[dt].x), pf8[s], o[dt], 0, 0, 0);
            }
#undef SA_VLOAD
#undef SA_VSTORE
            const float rl = 1.0f / l;
            if (hc < 4) {
#pragma unroll
                for (int dt = 0; dt < 8; ++dt) { u32x2 w; w.x = cvt_pk_bf16_s(o[dt][0] * rl, o[dt][1] * rl); w.y = cvt_pk_bf16_s(o[dt][2] * rl, o[dt][3] * rl);
                    *(u32x2*)(O + (size_t)q * DM + (4 * g + hc) * 128 + 16 * dt + 4 * rq) = w; } }
        }
        LDS_WAIT();
    }
#undef SA_KLOAD
}

typedef short s16x2 __attribute__((ext_vector_type(2)));
typedef __bf16 bfv2 __attribute__((ext_vector_type(2)));
__device__ __forceinline__ s16x2 cvt_bf2(float a, float b) { const f32x2 v = {a, b}; return __builtin_bit_cast(s16x2, __builtin_convertvector(v, bfv2)); }
template <int V>
__device__ __forceinline__ void indexer4(const Frame& F, const bf16_t* qkvi, bf16_t* SC) {
    const int lane = lane_id(), j = lane & 15, g = lane >> 4, w = F.wave, qg = w & 3, kh = w >> 2;
    LAS char* lds = (LAS char*)F.lds;
    const char* kib = (const char*)(qkvi + AKI_OFF);
    const int Lp = lane ^ ((lane >> 5) << 1);
    const unsigned dma_lo = (unsigned)(16 * (w >> 2) + (Lp >> 2)) * (unsigned)(A_INP * 2) + (unsigned)((w & 3) * 64 + (Lp & 3) * 16);
    const unsigned fo = (unsigned)(kh * 16384 + ((j * 64 + g * 16) ^ ((j >> 3) << 5)));
    const s16x2 zero2 = {0, 0};
#pragma unroll 1
    for (int x = F.bid; x < 256; x += F.G) {
        const int ns0 = (x >> 3) + 1, ns1 = ((511 - x) >> 3) + 1, NT = ns0 + ns1;
#define IX_DMA(n_) do { const int n2_ = (n_) < NT ? (n_) : NT - 1; const unsigned kn_ = 128u * (unsigned)(n2_ < ns0 ? n2_ : n2_ - ns0); LAS char* sb_ = lds + ((n_) & 3) * 32768 + w * 1024; \
        _Pragma("unroll") for (int i_ = 0; i_ < 4; ++i_) __builtin_amdgcn_global_load_lds((const unsigned*)(kib + (dma_lo + (kn_ + 32u * i_) * (unsigned)(A_INP * 2))), (LAS unsigned*)(sb_ + i_ * 8192), 16, 0, 0); } while (0)
        if (!(V & 2)) { IX_DMA(0); IX_DMA(1); IX_DMA(2); }
        bf16x8 bq[4][4]; u32x2 wown = {0u, 0u}; unsigned sofs = 0u;
#pragma unroll 1
        for (int n = 0; n < NT; ++n) {
            if (n == 0 || n == ns0) {
                const int q0 = 16 * (n == 0 ? x : 511 - x) + 4 * qg;
#pragma unroll
                for (int qi = 0; qi < 4; ++qi)
#pragma unroll
                    for (int kk = 0; kk < 4; ++kk) bq[qi][kk] = *(const bf16x8*)(qkvi + ((unsigned)(q0 + qi) * (unsigned)A_INP + (unsigned)(AQI_OFF + j * 128 + 32 * kk + 8 * g)));
                wown = *(const u32x2*)(qkvi + ((unsigned)(q0 + (j & 3)) * (unsigned)A_INP + (unsigned)(AWI_OFF + 4 * g)));
                sofs = (unsigned)(q0 + (j & 3)) * (unsigned)SEQ + (unsigned)(64 * kh + 16 * (j >> 2) + 4 * g);
                asm volatile("s_waitcnt vmcnt(0)" ::: "memory");
#pragma unroll
                for (int qi = 0; qi < 4; ++qi)
#pragma unroll
                    for (int kk = 0; kk < 4; ++kk) asm volatile("" : "+v"(bq[qi][kk]));
                asm volatile("" : "+v"(wown));
            } else if (!(V & 2)) asm volatile("s_waitcnt vmcnt(11)" ::: "memory");
            if (!(V & 4)) __builtin_amdgcn_s_barrier(); asm volatile("" ::: "memory");
            if (!(V & 2)) IX_DMA(n + 3);
            asm volatile("" ::: "memory");
            const unsigned key0 = 128u * (unsigned)(n < ns0 ? n : n - ns0);
            LAS char* sb = lds + (n & 3) * 32768;
            bf16x8 kf[2][4]; f32x4 acc[2][4]; f32x4 d2q[4];
            const f32x4 zero4 = (f32x4){0.f, 0.f, 0.f, 0.f};
#pragma unroll
            for (int qi = 0; qi < 4; ++qi) d2q[qi] = zero4;
#define IX_EPI(t_, qi_) do { if (V & 1) { d2q[qi_] += acc[(t_) & 1][qi_]; } else { const f32x4 ac_ = acc[(t_) & 1][qi_]; \
                const s16x2 lo_ = __builtin_elementwise_max(cvt_bf2(ac_[0], ac_[1]), zero2), hi_ = __builtin_elementwise_max(cvt_bf2(ac_[2], ac_[3]), zero2); \
                const s16x4 a2_ = {lo_[0], lo_[1], hi_[0], hi_[1]}; const bool on_ = j == 4 * (t_) + (qi_); const u32x2 ws_ = {on_ ? wown.x : 0u, on_ ? wown.y : 0u}; \
                d2q[qi_] = __builtin_amdgcn_mfma_f32_16x16x16bf16_1k(a2_, __builtin_bit_cast(s16x4, ws_), d2q[qi_], 0, 0, 0); } } while (0)
#pragma unroll
            for (int kk = 0; kk < 4; ++kk) kf[0][kk] = *(const LAS bf16x8*)(sb + fo + kk * 1024);
#pragma unroll
            for (int t = 0; t < 4; ++t) {
                if (t < 3) {
#pragma unroll
                    for (int kk = 0; kk < 4; ++kk) kf[(t + 1) & 1][kk] = *(const LAS bf16x8*)(sb + fo + (t + 1) * 4096 + kk * 1024); }
                __builtin_amdgcn_sched_barrier(0);
#pragma unroll
                for (int kk = 0; kk < 4; ++kk) {
#pragma unroll
                    for (int qi = 0; qi < 4; ++qi) acc[t & 1][qi] = __builtin_amdgcn_mfma_f32_16x16x32_bf16(bq[qi][kk], kf[t & 1][kk], kk ? acc[t & 1][qi] : zero4, 0, 0, 0);
                    if (t > 0) IX_EPI(t - 1, kk);
                    __builtin_amdgcn_sched_barrier(0);
                }
            }
#pragma unroll
            for (int qi = 0; qi < 4; ++qi) IX_EPI(3, qi);
#undef IX_EPI
            const f32x4 d2 = (d2q[0] + d2q[1]) + (d2q[2] + d2q[3]);
            const s16x2 o0 = cvt_bf2(d2[0], d2[1]), o1 = cvt_bf2(d2[2], d2[3]);
            u32x2 o; o.x = __builtin_bit_cast(unsigned, o0); o.y = __builtin_bit_cast(unsigned, o1);
            asm volatile("" ::: "memory");
            *(u32x2*)(SC + (sofs + key0)) = o;
            asm volatile("" ::: "memory");
        }
#undef IX_DMA
        asm volatile("s_waitcnt vmcnt(0)" ::: "memory"); __builtin_amdgcn_s_barrier(); asm volatile("" ::: "memory");
    }
}

template <int V>
__device__ __forceinline__ void indexer5(const Frame& F, const bf16_t* qkvi, bf16_t* SC) {
    const int lane = lane_id(), j = lane & 15, g = lane >> 4, w = F.wave, qg = w & 3, kh = w >> 2;
    LAS char* lds = (LAS char*)F.lds;
    const char* kib = (const char*)(qkvi + AKI_OFF);
    const int Lp = lane ^ ((lane >> 5) << 1);
    const unsigned dma_lo = (unsigned)(16 * (w >> 2) + (Lp >> 2)) * (unsigned)(A_INP * 2) + (unsigned)((w & 3) * 64 + (Lp & 3) * 16);
    const unsigned fo = (unsigned)(kh * 32768 + ((j * 64 + g * 16) ^ ((j >> 3) << 5)));
    const s16x2 zero2 = {0, 0};
#pragma unroll 1
    for (int x = F.bid; x < 256; x += F.G) {
        const int ns0 = (x >> 4) + 1, ns1 = ((511 - x) >> 4) + 1, NT = ns0 + ns1;
#define IX_DMA(n_) do { const unsigned kn_ = 256u * (unsigned)((n_) < ns0 ? (n_) : (n_) - ns0); LAS char* sb_ = lds + ((n_) & 1) * 65536 + w * 1024; \
        _Pragma("unroll") for (int i_ = 0; i_ < 8; ++i_) __builtin_amdgcn_global_load_lds((const unsigned*)(kib + (dma_lo + (kn_ + 32u * i_) * (unsigned)(A_INP * 2))), (LAS unsigned*)(sb_ + i_ * 8192), 16, 0, 0); } while (0)
        if (!(V & 2)) IX_DMA(0);
        bf16x8 bq[4][4]; u32x2 wown = {0u, 0u}; unsigned sofs = 0u;
#pragma unroll 1
        for (int n = 0; n < NT; ++n) {
            if (n == 0 || n == ns0) {
                const int q0 = 16 * (n == 0 ? x : 511 - x) + 4 * qg;
#pragma unroll
                for (int qi = 0; qi < 4; ++qi)
#pragma unroll
                    for (int kk = 0; kk < 4; ++kk) bq[qi][kk] = *(const bf16x8*)(qkvi + ((unsigned)(q0 + qi) * (unsigned)A_INP + (unsigned)(AQI_OFF + j * 128 + 32 * kk + 8 * g)));
                wown = *(const u32x2*)(qkvi + ((unsigned)(q0 + (j & 3)) * (unsigned)A_INP + (unsigned)(AWI_OFF + 4 * g)));
                sofs = (unsigned)(q0 + (j & 3)) * (unsigned)SEQ + (unsigned)(128 * kh + 16 * (j >> 2) + 4 * g);
                asm volatile("s_waitcnt vmcnt(0)" ::: "memory");
#pragma unroll
                for (int qi = 0; qi < 4; ++qi)
#pragma unroll
                    for (int kk = 0; kk < 4; ++kk) asm volatile("" : "+v"(bq[qi][kk]));
                asm volatile("" : "+v"(wown));
            } else if (!(V & 2)) asm volatile("s_waitcnt vmcnt(2)" ::: "memory");
            if (!(V & 4)) __builtin_amdgcn_s_barrier(); asm volatile("" ::: "memory");
            if (!(V & 2) && n + 1 < NT) IX_DMA(n + 1);
            asm volatile("" ::: "memory");
            const unsigned key0 = 256u * (unsigned)(n < ns0 ? n : n - ns0);
#pragma unroll 1
            for (int hf = 0; hf < 2; ++hf) {
            LAS char* sb = lds + (n & 1) * 65536 + hf * 16384;
            bf16x8 kf[2][4]; f32x4 acc[2][4]; f32x4 d2q[4];
            const f32x4 zero4 = (f32x4){0.f, 0.f, 0.f, 0.f};
#pragma unroll
            for (int qi = 0; qi < 4; ++qi) d2q[qi] = zero4;
#define IX_EPI(t_, qi_) do { if (V & 1) { d2q[qi_] += acc[(t_) & 1][qi_]; } else { const f32x4 ac_ = acc[(t_) & 1][qi_]; \
                const s16x2 lo_ = __builtin_elementwise_max(cvt_bf2(ac_[0], ac_[1]), zero2), hi_ = __builtin_elementwise_max(cvt_bf2(ac_[2], ac_[3]), zero2); \
                const s16x4 a2_ = {lo_[0], lo_[1], hi_[0], hi_[1]}; const bool on_ = j == 4 * (t_) + (qi_); const u32x2 ws_ = {on_ ? wown.x : 0u, on_ ? wown.y : 0u}; \
                d2q[qi_] = __builtin_amdgcn_mfma_f32_16x16x16bf16_1k(a2_, __builtin_bit_cast(s16x4, ws_), d2q[qi_], 0, 0, 0); } } while (0)
#pragma unroll
            for (int kk = 0; kk < 4; ++kk) kf[0][kk] = *(const LAS bf16x8*)(sb + fo + kk * 1024);
#pragma unroll
            for (int t = 0; t < 4; ++t) {
                if (t < 3) {
#pragma unroll
                    for (int kk = 0; kk < 4; ++kk) kf[(t + 1) & 1][kk] = *(const LAS bf16x8*)(sb + fo + (t + 1) * 4096 + kk * 1024); }
                __builtin_amdgcn_sched_barrier(0);
#pragma unroll
                for (int kk = 0; kk < 4; ++kk) {
                    __builtin_amdgcn_s_setprio(1);
#pragma unroll
                    for (int qi = 0; qi < 4; ++qi) acc[t & 1][qi] = __builtin_amdgcn_mfma_f32_16x16x32_bf16(bq[qi][kk], kf[t & 1][kk], kk ? acc[t & 1][qi] : zero4, 0, 0, 0);
                    __builtin_amdgcn_s_setprio(0);
                    if (t > 0) IX_EPI(t - 1, kk);
                    __builtin_amdgcn_sched_barrier(0);
                }
            }
#pragma unroll
            for (int qi = 0; qi < 4; ++qi) IX_EPI(3, qi);
#undef IX_EPI
            const f32x4 d2 = (d2q[0] + d2q[1]) + (d2q[2] + d2q[3]);
            const s16x2 o0 = cvt_bf2(d2[0], d2[1]), o1 = cvt_bf2(d2[2], d2[3]);
            u32x2 o; o.x = __builtin_bit_cast(unsigned, o0); o.y = __builtin_bit_cast(unsigned, o1);
            asm volatile("" ::: "memory");
            *(u32x2*)(SC + (sofs + key0 + 64u * (unsigned)hf)) = o;
            asm volatile("" ::: "memory");
            }
        }
#undef IX_DMA
        asm volatile("s_waitcnt vmcnt(0)" ::: "memory"); __builtin_amdgcn_s_barrier(); asm volatile("" ::: "memory");
    }
}

template <int J>
__device__ __forceinline__ void mixer_a(const Frame& F, KP P, const XcdBarrier& bar, bool from_x) {
    unsigned char* ws = G(P.ws); constexpr int L = 3 * J;
    float* h = (float*)(ws + WS_H); bf16_t* hn = (bf16_t*)(ws + WS_HN); const float* hsrc = from_x ? G(P.x) : h;
    bf16_t* qkvi = (bf16_t*)(ws + MA_QKVI); bf16_t* sc = (bf16_t*)(ws + MA_SC); int* idx = (int*)(ws + MA_IDX); bf16_t* ob = (bf16_t*)(ws + MA_O);
    const unsigned char* wa = ws + (J ? WA1 : WA0);
    if constexpr (J != 0) { norm_rows<false>(F, hsrc, G(P.attn_norm) + L * DM, hn); GRID_BAR(); }
    run_gemm<pg8::EpiRope<SelAin>, pg8::BMapPerm>(F, hn, DM, (const bf16_t*)wa, DM, DM, A_INP, pg8::EpiRope<SelAin>{qkvi, A_INP, (const f32x2*)(ws + WS_CS), ws + WS_KV8});
    GRID_BAR();
#ifdef IDX_GEMM
    { int kdim = 128; asm volatile("" : "+s"(kdim));
      pg8::Gemm g{qkvi + AKI_OFF, qkvi + AQI_OFF, A_INP, A_INP, kdim}; pg8::IdxOrder S{F.G, F.bid};
      pg8::gemm_phase<pg8::EpiIdx, pg8::IdxOrder, pg8::BMapIdx>(F.lds, F.wave, g, S, pg8::EpiIdx{qkvi + AWI_OFF, A_INP, sc, (LAS char*)F.lds + MISC_OFF + 4096}); }
#else
    indexer5<0>(F, qkvi, sc);
#endif
#ifdef PROBE_IDX2
    __syncthreads();
    indexer5<PROBE_IDX2>(F, qkvi, sc + (64u << 20));
#endif
#ifdef PROBE_IDX2_OLD
    __syncthreads();
    { int kdim = 128; asm volatile("" : "+s"(kdim));
      pg8::Gemm g{qkvi + AKI_OFF, qkvi + AQI_OFF, A_INP, A_INP, kdim}; pg8::IdxOrder S{F.G, F.bid};
      pg8::gemm_phase<pg8::EpiIdx, pg8::IdxOrder, pg8::BMapIdx>(F.lds, F.wave, g, S, pg8::EpiIdx{qkvi + AWI_OFF, A_INP, sc, (LAS char*)F.lds + MISC_OFF + 4096}); }
#endif
    GRID_BAR();
    for (int rep_ = 0; rep_ < REP_TOPK; ++rep_) topk_rows2(F, sc, idx);
    GRID_BAR();
    for (int rep_ = 0; rep_ < REP_SPARSE; ++rep_) sparse_attn4(F, P, qkvi, ws + WS_KV8, idx, ob);
#ifdef PROBE_SPARSE2
    sparse_attn3(F, P, qkvi, ws + WS_KV8, idx, (bf16_t*)(ws + MA_SC), PROBE_SPARSE2 == 2);
#endif
    GRID_BAR();
    run_gemm<pg8::EpiResid, pg8::BMapPlain>(F, ob, DM, (const bf16_t*)(wa + W_AIN), DM, DM, DM, pg8::EpiResid{hsrc, h, DM});
    GRID_BAR();
}
#ifndef MIX_A
#define MIX_A 1
#endif
#ifndef MIX_B
#define MIX_B 1
#endif
#ifndef MIX_C
#define MIX_C 1
#endif

template <int L>
__device__ __forceinline__ void ffn_ple(const Frame& F, KP P, const XcdBarrier& bar) {
    unsigned char* ws = G(P.ws); unsigned char* wl = ws + WL0 + (size_t)L * WL_SIZE;
    float* h = (float*)(ws + WS_H); bf16_t* hn = (bf16_t*)(ws + WS_HN); bf16_t* act = (bf16_t*)(ws + WS_ACT); bf16_t* proj = (bf16_t*)(ws + WS_PROJ);
    for (int rep_ = 0; rep_ < REP_NORM; ++rep_) norm_rows<false>(F, h, G(P.ffn_norm) + L * DM, hn);
    GRID_BAR();
    for (int rep_ = 0; rep_ < REP_FFNIN; ++rep_) run_gemm<pg8::EpiSwiGLU, pg8::BMapPerm>(F, hn, DM, (const bf16_t*)(wl + WL_FIN), DM, DM, 2 * FFH, pg8::EpiSwiGLU{act, FFH});
#ifdef PROBE_FFN_NULL
    __syncthreads();
    run_gemm<pg8::EpiNull, pg8::BMapPerm>(F, hn, DM, (const bf16_t*)(wl + WL_FIN), DM, DM, 2 * FFH, pg8::EpiNull{(float*)(ws + WS_PROJ)});
#endif
#ifdef PROBE_FFN_DUP
    __syncthreads();
    run_gemm<pg8::EpiSwiGLU, pg8::BMapPerm>(F, hn, DM, (const bf16_t*)(wl + WL_FIN), DM, DM, 2 * FFH, pg8::EpiSwiGLU{act, FFH});
#endif
    { pg8::Gemm g{(const bf16_t*)(ws + WS_PB) + (size_t)L * SEQ * PLE, (const bf16_t*)(wl + WL_PROJ), PLE, PLE, PLE}; pg8::UpperHalfOrder S; S.init(SEQ, DM, F.G, F.bid);
      pg8::gemm_phase<pg8::EpiBf16, pg8::UpperHalfOrder, pg8::BMapPerm>(F.lds, F.wave, g, S, pg8::EpiBf16{proj, DM}); }
    GRID_BAR();
    run_gemm<pg8::EpiResid, pg8::BMapPlain>(F, act, FFH, (const bf16_t*)(wl + WL_FOUT), FFH, FFH, DM, pg8::EpiResid{h, h, DM});
    GRID_BAR();
    norm_rows<false>(F, h, G(P.ple_norm) + L * DM, hn);
    GRID_BAR();
    run_gemm<pg8::EpiPLE, pg8::BMapPlain>(F, hn, DM, (const bf16_t*)(wl + WL_GATE), DM, DM, DM, pg8::EpiPLE{h, proj, DM});
    GRID_BAR();
}
__device__ __forceinline__ void copy_rows(const Frame& F, const float* src, float* dst) {
    const int gt = F.bid * NTHREADS + F.wave * 64 + lane_id(), NT = F.G * NTHREADS;
    for (int i = gt; i < SEQ * DM / 4; i += NT) ((f32x4*)dst)[i] = ((const f32x4*)src)[i];
}

__global__ void __launch_bounds__(NTHREADS, 2) mega_fwd(Params Parg) {
    extern __shared__ __attribute__((aligned(16))) unsigned char lds_raw[];
    Frame F;
    F.lds = (LAS unsigned char*)lds_raw;
    F.wave = __builtin_amdgcn_readfirstlane((int)threadIdx.x >> 6);
    F.G = gridDim.x; F.bid = blockIdx.x; F.gw = F.bid * NWAVES + F.wave; F.NGW = F.G * NWAVES;
    volatile LAS unsigned* MISC = (volatile LAS unsigned*)(F.lds + MISC_OFF);
#ifdef PROBE_ZERO_LDS
    for (int i_ = threadIdx.x; i_ < LDS_BYTES / 4; i_ += NTHREADS) ((LAS unsigned*)F.lds)[i_] = 0u;
    __syncthreads();
#endif
    if (threadIdx.x < 64) MISC[threadIdx.x] = 0u;
    __syncthreads();
    unsigned* ctl = (unsigned*)(G(kparams()->ws) + WS_CTL);
    XcdBarrier bar = xcd_barrier_post(ctl + CW_BAR, MISC + 8, F.wave);

    for (int rep_ = 0; rep_ < REP_PRO; ++rep_) p0_prologue(F, *kparams());
#if MIX_A
    { KP P = *kparams(); norm_rows<false>(F, G(P.x), G(P.attn_norm), (bf16_t*)(G(P.ws) + WS_HN)); }
#endif
    GRID_BAR();
#if MIX_A
    mixer_a<0>(F, *kparams(), bar, true);
#else
    copy_rows(F, G(kparams()->x), (float*)(G(kparams()->ws) + WS_H)); GRID_BAR();
#endif
    ffn_ple<0>(F, *kparams(), bar);
#if MIX_B
    mixer_b(F, *kparams(), bar);
#endif
    ffn_ple<1>(F, *kparams(), bar);
#if MIX_C
    mixer_c(F, *kparams(), bar);
#endif
    ffn_ple<2>(F, *kparams(), bar);
#if MIX_A
    mixer_a<1>(F, *kparams(), bar, false);
#endif
    ffn_ple<3>(F, *kparams(), bar);
    { KP P = *kparams(); norm_rows<true>(F, (const float*)(G(P.ws) + WS_H), G(P.final_norm), G(P.out)); }
}

extern "C" void kernel_launch(void* const* d_in, const int* in_sizes, int n_in, void* d_out, int out_size, void* d_ws, size_t ws_size, hipStream_t stream) {
    static int grid = 0;
    if (grid == 0) {
        if (n_in != 23 || in_sizes[0] != SEQ * DM || out_size != SEQ * DM || ws_size < WS_END) {
            fprintf(stderr, "kernel_launch: unexpected shapes (n_in %d, in0 %d, out %d, ws %zu < %zu); nothing launched\n", n_in, n_in > 0 ? in_sizes[0] : -1, out_size, ws_size, (size_t)WS_END); grid = -1; return; }
        int dev = 0, cus = 0, per_cu = 0;
        if (hipGetDevice(&dev) != hipSuccess || hipDeviceGetAttribute(&cus, hipDeviceAttributeMultiprocessorCount, dev) != hipSuccess) { grid = -1; return; }
        if (hipFuncSetAttribute((const void*)mega_fwd, hipFuncAttributeMaxDynamicSharedMemorySize, LDS_BYTES) != hipSuccess) { fprintf(stderr, "kernel_launch: hipFuncSetAttribute failed\n"); grid = -1; return; }
        if (hipOccupancyMaxActiveBlocksPerMultiprocessor(&per_cu, (const void*)mega_fwd, NTHREADS, LDS_BYTES) != hipSuccess || per_cu < 1)
            fprintf(stderr, "kernel_launch: note: occupancy query reports %d workgroups per CU\n", per_cu);
        (void)hipGetLastError();
        grid = cus;
    }
    if (grid < 0) return;
    if (hipMemsetAsync((char*)d_ws + WS_CTL, 0, CTL_ZERO_BYTES, stream) != hipSuccess) { fprintf(stderr, "kernel_launch: memset failed\n"); return; }
    Params p{};
    p.x = (const float*)d_in[0]; p.p = (const float*)d_in[1]; p.pos = (const int*)d_in[2]; p.t5 = (const float*)d_in[3];
    p.a_w_in = (const float*)d_in[4]; p.a_w_out = (const float*)d_in[5]; p.b_w_in = (const float*)d_in[6]; p.b_rel = (const float*)d_in[7]; p.b_w_out = (const float*)d_in[8];
    p.c_w_down = (const float*)d_in[9]; p.c_qn = (const float*)d_in[10]; p.c_kvn = (const float*)d_in[11]; p.c_w_uq = (const float*)d_in[12]; p.c_w_ukv = (const float*)d_in[13]; p.c_w_out = (const float*)d_in[14];
    p.attn_norm = (const float*)d_in[15]; p.ffn_norm = (const float*)d_in[16]; p.ffn_w_in = (const float*)d_in[17]; p.ffn_w_out = (const float*)d_in[18];
    p.ple_norm = (const float*)d_in[19]; p.ple_w_gate = (const float*)d_in[20]; p.ple_w_proj = (const float*)d_in[21]; p.final_norm = (const float*)d_in[22];
    p.out = (float*)d_out; p.ws = (unsigned char*)d_ws;
    hipLaunchKernelGGL(mega_fwd, dim3(grid), dim3(NTHREADS), LDS_BYTES, stream, p);
    const hipError_t le = hipPeekAtLastError();
    if (le != hipSuccess) fprintf(stderr, "kernel_launch: launch failed: %s\n", hipGetErrorName(le));
}
```
